# Optimizing an MI355X kernel written in HIP

```python
import math
import jax, jax.numpy as jnp
from jax import lax
import numpy as np

D_MODEL = 1024
BATCH = 8
SEQ = 2048
DEPTH = 1
DEC_BATCH = 128
DEC_SEQ = 4
PAST_LEN = 16384
PAGE_SIZE = 128

D_MIX = D_MODEL
D_POOL = D_MIX // 2
POOL_WINDOWS = (2, 4, 8, 16)
N_POOL_GROUPS = len(POOL_WINDOWS)
POOL_GROUP_DIM = D_POOL // N_POOL_GROUPS
POOL_BUF = max(POOL_WINDOWS) - 1
D_MLSTM = D_MIX - D_POOL
N_HEADS = 4
HEAD_DIM = D_MLSTM // N_HEADS
CHUNK = 64
D_IN = D_POOL + 4 * D_MLSTM + 2 * N_HEADS
SPLITS = (D_POOL, D_POOL + D_MLSTM, D_POOL + 2 * D_MLSTM, D_POOL + 3 * D_MLSTM,
          D_POOL + 4 * D_MLSTM, D_POOL + 4 * D_MLSTM + N_HEADS)
N_KEYS = 128
N_EXPERTS = N_KEYS * N_KEYS
PEER_HEADS = 8
D_KEY = 256
HALF_KEY = D_KEY // 2
TOPK = 16
TOKEN_BLOCK = 256
ALPHA = (2.0 * DEPTH) ** 0.25
BETA = (8.0 * DEPTH) ** -0.25
LN_EPS = 1e-5

kernel_name = 'hymba_pool_mlstm_peer_adaln_step'


def _ln(x, gain=None, bias=None):
    xf = x.astype(jnp.float32)
    mu = jnp.mean(xf, -1, keepdims=True)
    var = jnp.mean(jnp.square(xf - mu), -1, keepdims=True)
    y = (xf - mu) * lax.rsqrt(var + LN_EPS)
    if gain is not None:
        y = y * gain.astype(jnp.float32) + bias.astype(jnp.float32)
    return y.astype(x.dtype)


def _pool_mix(u, buf, pos0, w_pool, pool_scale):
    B, T, _ = u.shape
    z = jnp.concatenate([buf.astype(u.dtype), u], axis=1)
    cs = jnp.concatenate([jnp.zeros((B, 1, D_POOL), jnp.float32),
                          jnp.cumsum(z.astype(jnp.float32), axis=1)], axis=1)
    end = cs[:, POOL_BUF + 1:POOL_BUF + 1 + T]
    pos = pos0 + jnp.arange(T)
    means = []
    for g, w in enumerate(POOL_WINDOWS):
        sl = slice(g * POOL_GROUP_DIM, (g + 1) * POOL_GROUP_DIM)
        start = cs[:, POOL_BUF + 1 - w:POOL_BUF + 1 - w + T, sl]
        cnt = jnp.minimum(pos + 1, w).astype(jnp.float32)[None, :, None]
        means.append((end[:, :, sl] - start) / cnt)
    d = jnp.concatenate(means, -1) - u.astype(jnp.float32)
    d = d.reshape(B, T, N_POOL_GROUPS, POOL_GROUP_DIM).astype(u.dtype)
    y = jnp.einsum('btgc,gcd->btgd', d, w_pool).reshape(B, T, D_POOL)
    return y * pool_scale, z[:, -POOL_BUF:]


def _mlstm(q, k, v, ig, lf, S0, n0, m0):
    B, H, T, DH = q.shape
    L = CHUNK if T % CHUNK == 0 else T
    nc = T // L

    def split(a):
        return jnp.moveaxis(a.reshape(B, H, nc, L, *a.shape[3:]), 2, 0)

    causal = jnp.tril(jnp.ones((L, L), bool))

    def step(carry, inp):
        S, n, m = carry
        qc, kc, vc, ic, fc = inp
        b = jnp.cumsum(fc, axis=-1)
        a_prev = b + m[..., None]
        d = b[..., :, None] - b[..., None, :] + ic[..., None, :]
        d = jnp.where(causal, d, -jnp.inf)
        m_t = jnp.maximum(a_prev, jnp.max(d, -1))
        w_prev = jnp.exp(a_prev - m_t)
        qk = jnp.einsum('bhtd,bhsd->bhts', qc, kc) * jnp.exp(d - m_t[..., None])
        num = w_prev[..., None] * jnp.einsum('bhtd,bhde->bhte', qc, S) + jnp.einsum('bhts,bhse->bhte', qk, vc)
        den = w_prev * jnp.einsum('bhtd,bhd->bht', qc, n) + jnp.sum(qk, -1)
        h = num / jnp.maximum(jnp.abs(den), jnp.exp(-m_t))[..., None]
        m_new = m_t[..., -1]
        g_prev = jnp.exp(b[..., -1] + m - m_new)
        g_in = jnp.exp(b[..., -1:] - b + ic - m_new[..., None])
        kg = kc * g_in[..., None]
        S_new = g_prev[..., None, None] * S + jnp.einsum('bhsd,bhse->bhde', kg, vc)
        n_new = g_prev[..., None] * n + jnp.sum(kg, -2)
        return (S_new, n_new, m_new), h

    (S, n, m), hs = lax.scan(step, (S0, n0, m0), (split(q), split(k), split(v), split(ig), split(lf)))
    h = jnp.moveaxis(hs, 0, 2).reshape(B, H, T, DH)
    return h, S, n, m


def _mixer(u, pool_buf, S0, n0, m0, pos0, w_in, b_in, w_pool, pool_scale, mh_norm_g, w_out):
    B, T, _ = u.shape
    p = u @ w_in + b_in
    pu, q, k, v, o, gi, gf = jnp.split(p, SPLITS, axis=-1)
    y_pool, pool_new = _pool_mix(pu, pool_buf, pos0, w_pool, pool_scale)

    def heads(a):
        return a.reshape(B, T, N_HEADS, HEAD_DIM).transpose(0, 2, 1, 3).astype(jnp.float32)

    qh, kh, vh = heads(q), heads(k) * (HEAD_DIM ** -0.5), heads(v)
    ig = gi.astype(jnp.float32).transpose(0, 2, 1)
    lf = jax.nn.log_sigmoid(gf.astype(jnp.float32)).transpose(0, 2, 1)
    h, S, n, m = _mlstm(qh, kh, vh, ig, lf, S0.astype(jnp.float32), n0.astype(jnp.float32), m0.astype(jnp.float32))
    h = _ln(h).transpose(0, 2, 1, 3).reshape(B, T, D_MLSTM)
    y_ml = (h * mh_norm_g.astype(jnp.float32) * jax.nn.sigmoid(o.astype(jnp.float32))).astype(u.dtype)
    y = jnp.concatenate([y_pool, y_ml], -1) @ w_out
    return y, pool_new, S, n, m


def _peer(u, w_q, sub_keys, u_tab, v_tab):
    B, T, D = u.shape
    n = B * T
    blk = min(TOKEN_BLOCK, n)
    nb = -(-n // blk)
    xp = jnp.pad(u.reshape(n, D), ((0, nb * blk - n), (0, 0))).reshape(nb, blk, D)
    keys = sub_keys.astype(jnp.float32)

    def one(xb):
        q = (xb @ w_q).reshape(blk, PEER_HEADS, 2, HALF_KEY).astype(jnp.float32)
        s = jnp.einsum('nhpc,hpkc->nhpk', q, keys)
        sv, si = lax.top_k(s, TOPK)
        comb = (sv[:, :, 0, :, None] + sv[:, :, 1, None, :]).reshape(blk, PEER_HEADS, TOPK * TOPK)
        cidx = (si[:, :, 0, :, None] * N_KEYS + si[:, :, 1, None, :]).reshape(blk, PEER_HEADS, TOPK * TOPK)
        top, sel = lax.top_k(comb, TOPK)
        eidx = jnp.take_along_axis(cidx, sel, axis=-1)
        g = jax.nn.softmax(top, axis=-1)
        act = jax.nn.gelu(jnp.einsum('nd,nhkd->nhk', xb, u_tab[eidx]).astype(jnp.float32), approximate=False)
        coef = (g * act).astype(xb.dtype)
        return jnp.einsum('nhk,nhkd->nd', coef, v_tab[eidx])

    y = lax.map(one, xp).reshape(nb * blk, D)[:n]
    return y.reshape(B, T, D)


def _layer(x, c, pool_buf, S0, n0, m0, pos0, w_mod, b_mod, w_in, b_in, w_pool, pool_scale,
           mh_norm_g, w_out, ln1_g, ln1_b, w_q, sub_keys, u_tab, v_tab, ln2_g, ln2_b):
    mod = jax.nn.silu(c) @ w_mod + b_mod
    sh1, sc1, g1, sh2, sc2, g2 = [a[:, None, :] for a in jnp.split(mod, 6, axis=-1)]
    u1 = _ln(x) * (1 + sc1) + sh1
    y, pool_new, S, n, m = _mixer(u1, pool_buf, S0, n0, m0, pos0, w_in, b_in, w_pool, pool_scale, mh_norm_g, w_out)
    x = _ln(ALPHA * x + (1 + g1) * y, ln1_g, ln1_b)
    u2 = _ln(x) * (1 + sc2) + sh2
    y = _peer(u2, w_q, sub_keys, u_tab, v_tab)
    x = _ln(ALPHA * x + (1 + g2) * y, ln2_g, ln2_b)
    return x, pool_new, S, n, m


def setup_inputs(seed: int = 0) -> dict:
    key = jax.random.key(seed)
    ks = jax.random.split(key, 32)

    def nrm(k, shape, s):
        return jax.random.normal(k, shape, jnp.float32) * s

    L = DEPTH
    b_in = nrm(ks[12], (L, D_IN), 0.02)
    b_in = b_in.at[:, D_IN - N_HEADS:].add(jnp.linspace(3.0, 6.0, N_HEADS))
    return {
        'x_prompt': nrm(ks[0], (BATCH, SEQ, D_MODEL), 1.0),
        'x_sample': nrm(ks[1], (DEC_BATCH, DEC_SEQ, D_MODEL), 1.0),
        'c_prompt': nrm(ks[2], (BATCH, D_MODEL), 1.0),
        'c_sample': nrm(ks[3], (DEC_BATCH, D_MODEL), 1.0),
        'state_pool': nrm(ks[4], (L, DEC_BATCH, POOL_BUF, D_POOL), 1.0),
        'state_C': nrm(ks[5], (L, DEC_BATCH, N_HEADS, HEAD_DIM, HEAD_DIM), 0.1),
        'state_n': nrm(ks[6], (L, DEC_BATCH, N_HEADS, HEAD_DIM), 0.3),
        'state_m': nrm(ks[7], (L, DEC_BATCH, N_HEADS), 1.0),
        'w_mod': nrm(ks[8], (L, D_MODEL, 6 * D_MODEL), 0.1 * D_MODEL ** -0.5),
        'b_mod': nrm(ks[9], (L, 6 * D_MODEL), 0.02),
        'w_in': nrm(ks[10], (L, D_MODEL, D_IN), D_MODEL ** -0.5),
        'b_in': b_in,
        'w_pool': nrm(ks[13], (L, N_POOL_GROUPS, POOL_GROUP_DIM, POOL_GROUP_DIM), POOL_GROUP_DIM ** -0.5),
        'pool_scale': 1.0 + nrm(ks[14], (L, D_POOL), 0.1),
        'mh_norm_g': 1.0 + nrm(ks[15], (L, D_MLSTM), 0.1),
        'w_out': nrm(ks[16], (L, D_MIX, D_MODEL), BETA * D_MIX ** -0.5),
        'ln1_g': 1.0 + nrm(ks[17], (L, D_MODEL), 0.1),
        'ln1_b': nrm(ks[18], (L, D_MODEL), 0.02),
        'w_q': nrm(ks[19], (L, D_MODEL, PEER_HEADS * D_KEY), D_MODEL ** -0.5),
        'sub_keys': nrm(ks[20], (L, PEER_HEADS, 2, N_KEYS, HALF_KEY), HALF_KEY ** -0.5),
        'u_tab': nrm(ks[21], (L, N_EXPERTS, D_MODEL), D_MODEL ** -0.5),
        'v_tab': nrm(ks[22], (L, N_EXPERTS, D_MODEL), BETA * PEER_HEADS ** -0.5),
        'ln2_g': 1.0 + nrm(ks[23], (L, D_MODEL), 0.1),
        'ln2_b': nrm(ks[24], (L, D_MODEL), 0.02),
    }


def reference(x_prompt, x_sample, c_prompt, c_sample, state_pool, state_C, state_n, state_m,
              w_mod, b_mod, w_in, b_in, w_pool, pool_scale, mh_norm_g, w_out, ln1_g, ln1_b,
              w_q, sub_keys, u_tab, v_tab, ln2_g, ln2_b):
    B = x_prompt.shape[0]
    yp, ys = x_prompt, x_sample
    pp, Cp, np_, mp, ps, Cs, ns, ms = [], [], [], [], [], [], [], []
    for l in range(DEPTH):
        wl = (w_mod[l], b_mod[l], w_in[l], b_in[l], w_pool[l], pool_scale[l], mh_norm_g[l], w_out[l],
              ln1_g[l], ln1_b[l], w_q[l], sub_keys[l], u_tab[l], v_tab[l], ln2_g[l], ln2_b[l])
        yp, a, b, c, d = _layer(yp, c_prompt,
                                jnp.zeros((B, POOL_BUF, D_POOL), x_prompt.dtype),
                                jnp.zeros((B, N_HEADS, HEAD_DIM, HEAD_DIM), jnp.float32),
                                jnp.zeros((B, N_HEADS, HEAD_DIM), jnp.float32),
                                jnp.zeros((B, N_HEADS), jnp.float32), 0, *wl)
        pp.append(a); Cp.append(b); np_.append(c); mp.append(d)
        ys, a, b, c, d = _layer(ys, c_sample, state_pool[l], state_C[l], state_n[l], state_m[l], PAST_LEN, *wl)
        ps.append(a); Cs.append(b); ns.append(c); ms.append(d)
    sd = state_C.dtype
    pool_p = jnp.stack(pp).astype(state_pool.dtype)
    C_p = jnp.stack(Cp).astype(sd)
    n_p = jnp.stack(np_).astype(state_n.dtype)
    m_p = jnp.stack(mp).astype(state_m.dtype)
    pool_s = jnp.stack(ps).astype(state_pool.dtype)
    C_s = jnp.stack(Cs).astype(sd)
    n_s = jnp.stack(ns).astype(state_n.dtype)
    m_s = jnp.stack(ms).astype(state_m.dtype)
    return (yp, ys, pool_p, C_p, n_p, m_p, pool_s, C_s, n_s, m_s)
```

```cpp
#include <hip/hip_runtime.h>
#include <hip/hip_cooperative_groups.h>
#include <cstdio>
#include <cstdint>
namespace cg = cooperative_groups;


#ifndef UFP4
#define UFP4 1
#endif
#ifndef FUSED
#define FUSED 1
#endif

#define DEVI __device__ __forceinline__
#define TID ((int)(threadIdx.x & 255u))
#define VHALF ((int)(threadIdx.x >> 8))
#define NVB ((int)gridDim.x * 2)
#define LAS __attribute__((address_space(3)))

typedef unsigned short bf16_t;
typedef short bf16x8 __attribute__((ext_vector_type(8)));
typedef short s16x4 __attribute__((ext_vector_type(4)));
typedef float f32x4 __attribute__((ext_vector_type(4)));
typedef unsigned u32x4 __attribute__((ext_vector_type(4)));
typedef __bf16 bf2_t __attribute__((ext_vector_type(2)));

constexpr int D = 1024, NTP = 16384, NTS = 512, NT = NTP + NTS, SEQ = 2048, NSEQ = 136;
constexpr int DIN = 2568, NP = 2560, NMOD = 6144;
constexpr int NPH = 11;
constexpr float ALPHA = 1.189207115002721f;
constexpr float LN_EPS = 1e-5f;
constexpr float KSCALE = 0.08838834764831845f;

constexpr size_t O_Y = 0, O_POOLP = 17301504, O_CP = 17362944, O_NP = 17887232, O_MP = 17891328,
                 O_POOLS = 17891360, O_CS = 18874400, O_NS = 27263008, O_MS = 27328544;

constexpr size_t WS_CTL = 0;
constexpr size_t WS_MOD = 65536;
constexpr size_t WS_GATES = WS_MOD + 6291456;
constexpr size_t WS_MST = WS_GATES + 540672;
constexpr size_t WS_NST = WS_MST + 8192;
constexpr size_t WS_WTIN = WS_NST + 524288;
constexpr size_t WS_WTOUT = WS_WTIN + 5242880;
constexpr size_t WS_WTQ = WS_WTOUT + 2097152;
constexpr size_t WS_WTMOD = WS_WTQ + 4194304;
constexpr size_t WS_GA = WS_WTMOD;
constexpr size_t WS_BB = WS_GA + 262144;
constexpr size_t WS_RR = WS_BB + 262144;
constexpr size_t WS_RPM = WS_RR + 262144;
constexpr size_t WS_BCH = WS_RPM + 262144;
constexpr size_t WS_WTPOOL = WS_WTMOD + 12582912;
constexpr size_t WS_KEYS = WS_WTPOOL + 131072;
constexpr size_t WS_AMOD = WS_KEYS + 524288;
constexpr size_t WS_UT = WS_AMOD + 524288;
constexpr size_t WS_USC = WS_UT + 16777216;
constexpr size_t WS_VT = WS_UT + 33554432;
constexpr size_t WS_VSC = WS_VT + 16777216;
constexpr size_t WS_BUFA = WS_VT + 33554432;
constexpr size_t WS_BUFB = WS_BUFA + 34603008;
constexpr size_t WS_P = WS_BUFB + 34603008;
constexpr size_t WS_PART = WS_P;
constexpr size_t WS_Q = WS_P;
constexpr size_t WS_K16 = WS_P + 69206016;
constexpr size_t WS_EG = WS_BUFA;
constexpr size_t WS_GG = WS_EG + 8650752;
constexpr size_t WS_END = WS_P + 86507520;

constexpr int CW_BAR = 0;
constexpr int CW_CNT = 4096;

struct Params {
    const float *x_prompt, *x_sample, *c_prompt, *c_sample, *state_pool, *state_C, *state_n, *state_m;
    const float *w_mod, *b_mod, *w_in, *b_in, *w_pool, *pool_scale, *mh_norm_g, *w_out, *ln1_g, *ln1_b;
    const float *w_q, *sub_keys, *u_tab, *v_tab, *ln2_g, *ln2_b;
    float* out;
    unsigned char* ws;
};

typedef float f32x2 __attribute__((ext_vector_type(2)));
DEVI unsigned pack2(float lo, float hi) { const f32x2 v = {lo, hi}; const bf2_t b = __builtin_convertvector(v, bf2_t); return __builtin_bit_cast(unsigned, b); }
DEVI float dot2bf(unsigned a, unsigned b, float c) { return __builtin_amdgcn_fdot2_f32_bf16(__builtin_bit_cast(bf2_t, a), __builtin_bit_cast(bf2_t, b), c, false); }
DEVI float bf_lo(unsigned u) { return __uint_as_float(u << 16); }
DEVI float bf_hi(unsigned u) { return __uint_as_float(u & 0xFFFF0000u); }
DEVI float bf1(bf16_t h) { return __uint_as_float(((unsigned)h) << 16); }
DEVI float wave_sum(float v) {
#pragma unroll
    for (int o = 32; o > 0; o >>= 1) v += __shfl_xor(v, o);
    return v;
}
DEVI float sum16(float v) {
#pragma unroll
    for (int o = 8; o > 0; o >>= 1) v += __shfl_xor(v, o);
    return v;
}
DEVI float sumq(float v) {
    v += __shfl_xor(v, 16); v += __shfl_xor(v, 32); return v;
}
DEVI float logsigmoid(float x) { return fminf(x, 0.f) - log1pf(expf(-fabsf(x))); }
DEVI float sigmoidf_(float x) { return 1.f / (1.f + expf(-x)); }
DEVI float gelu_exact(float x) { return 0.5f * x * (1.f + erff(x * 0.7071067811865476f)); }
DEVI float scan_sum_incl(float v, int lane) {
#pragma unroll
    for (int o = 1; o < 64; o <<= 1) { float t = __shfl_up(v, o); if (lane >= o) v += t; }
    return v;
}
DEVI float scan_max_incl(float v, int lane) {
#pragma unroll
    for (int o = 1; o < 64; o <<= 1) { float t = __shfl_up(v, o); if (lane >= o) v = fmaxf(v, t); }
    return v;
}
DEVI const float* xrow_ptr(const Params& p, int tok) { return tok < NTP ? p.x_prompt + (size_t)tok * D : p.x_sample + (size_t)(tok - NTP) * D; }
DEVI int seq_of(int tok) { return tok < NTP ? (tok >> 11) : 8 + ((tok - NTP) >> 2); }

DEVI int key_enc(float f, int payload, int mask) { int b = __float_as_int(f); int k = b ^ ((b >> 31) & 0x7FFFFFFF); return (k & ~mask) | payload; }
DEVI float key_val(int k, int mask) { int k2 = k & ~mask; return __int_as_float(k2 ^ ((k2 >> 31) & 0x7FFFFFFF)); }

template <int N> DEVI void bitonic_sort_desc(int (&a)[N]) {
#pragma unroll
    for (int k = 2; k <= N; k <<= 1) {
#pragma unroll
        for (int j = k >> 1; j > 0; j >>= 1) {
#pragma unroll
            for (int i = 0; i < N; ++i) {
                const int l = i ^ j;
                if (l > i) {
                    const bool desc = ((i & k) == 0);
                    const int mx = max(a[i], a[l]), mn = min(a[i], a[l]);
                    a[i] = desc ? mx : mn; a[l] = desc ? mn : mx;
                }
            }
        }
    }
}
DEVI void bitonic_merge16_desc(int (&a)[16]) {
#pragma unroll
    for (int j = 8; j > 0; j >>= 1) {
#pragma unroll
        for (int i = 0; i < 16; ++i) {
            const int l = i ^ j;
            if (l > i) { const int mx = max(a[i], a[l]), mn = min(a[i], a[l]); a[i] = mx; a[l] = mn; }
        }
    }
}

#define XB_TMO      128
#define XB_XCNT(j)  (256  + 64 * (j))
#define XB_XSUB(j)  (1280 + 64 * (j))
#define XB_XGEN(j)  (2304 + 64 * (j))
#define XB_TOP      3328
#define XB_TOPGEN   3392
#define XCD_BAR_WORDS 3456
#define XB_SPIN_CAP (1u << 22)
DEVI unsigned xb_ld(unsigned* p) { return __hip_atomic_load(p, __ATOMIC_RELAXED, __HIP_MEMORY_SCOPE_AGENT); }
DEVI unsigned xb_add(unsigned* p, unsigned v) { return __hip_atomic_fetch_add(p, v, __ATOMIC_RELAXED, __HIP_MEMORY_SCOPE_AGENT); }
DEVI unsigned xb_xcc_id() { return (unsigned)__builtin_amdgcn_s_getreg((3 << 11) | 20) & 0xFu; }
#define XB_SPIN(cond, bar) do { unsigned _sp = 0; while (cond) { __builtin_amdgcn_s_sleep(1); \
    if ((++_sp & 255u) == 0u) { if (xb_ld(&(bar)[XB_TMO])) break; if (_sp > XB_SPIN_CAP) { atomicAdd(&(bar)[XB_TMO], 1u); break; } } } } while (0)
struct XcdBarrier { unsigned* bar; unsigned x; volatile LAS unsigned* st; };
DEVI XcdBarrier xcd_barrier_post(unsigned* bar, volatile LAS unsigned* st) {
    XcdBarrier b; b.bar = bar; b.x = xb_xcc_id(); b.st = st;
    if (threadIdx.x == 0) (void)xb_add(&bar[XB_XCNT(b.x)], 1u);
    return b;
}
DEVI void xcd_barrier_complete(unsigned* bar, unsigned x, unsigned& nloc, unsigned& nx) {
    const unsigned G = gridDim.x * gridDim.y * gridDim.z;
    unsigned sum, cnt, mine, sp = 0u;
    for (;;) {
        sum = 0u; cnt = 0u; mine = 0u;
#pragma unroll
        for (unsigned j = 0; j < 16; ++j) { const unsigned c = xb_ld(&bar[XB_XCNT(j)]); sum += c; cnt += (c > 0u) ? 1u : 0u; mine = (j == x) ? c : mine; }
        if (sum == G) break;
        __builtin_amdgcn_s_sleep(1);
        if ((++sp & 255u) == 0u) { if (xb_ld(&bar[XB_TMO])) break; if (sp > XB_SPIN_CAP) { atomicAdd(&bar[XB_TMO], 1u); break; } }
    }
    nloc = mine > 0u ? mine : 1u; nx = cnt > 0u ? cnt : 1u;
}
DEVI void xcd_barrier(const XcdBarrier& b) {
    asm volatile("s_waitcnt vmcnt(0)" ::: "memory");
    __syncthreads();
    if (threadIdx.x == 0) {
        unsigned* bar = b.bar;
        __builtin_amdgcn_s_waitcnt(0);
        unsigned nloc = b.st[0], nx = b.st[1];
        if (nloc == 0u) { xcd_barrier_complete(bar, b.x, nloc, nx); b.st[0] = nloc; b.st[1] = nx; }
        const unsigned old = xb_add(&bar[XB_XSUB(b.x)], 1u);
        const unsigned gen = old / nloc;
        if (old + 1u == (gen + 1u) * nloc) {
            __builtin_amdgcn_fence(__ATOMIC_RELEASE, "agent");
            asm volatile("s_waitcnt vmcnt(0)" ::: "memory");
            const unsigned og = xb_add(&bar[XB_TOP], 1u);
            const unsigned tg = og / nx;
            if (og + 1u == (tg + 1u) * nx) xb_add(&bar[XB_TOPGEN], 1u);
            else XB_SPIN(xb_ld(&bar[XB_TOPGEN]) == tg, bar);
            __builtin_amdgcn_fence(__ATOMIC_ACQUIRE, "agent");
            xb_add(&bar[XB_XGEN(b.x)], 1u);
            asm volatile("s_waitcnt vmcnt(0)" ::: "memory");
        } else {
            XB_SPIN(xb_ld(&bar[XB_XGEN(b.x)]) == gen, bar);
            __builtin_amdgcn_fence(__ATOMIC_ACQUIRE, "agent");
            asm volatile("s_waitcnt vmcnt(0)" ::: "memory");
        }
    }
    __syncthreads();
}

constexpr int SMEM_HALF = 73728;
constexpr int SMEM_BYTES = 2 * SMEM_HALF;
constexpr int LDS_DYN = SMEM_BYTES + 64;
constexpr int LDT = 72;
constexpr int LDW = 136;

DEVI void mma_lds128(const bf16_t* Al, const bf16_t* Bl, f32x4 (&acc)[4][4]) {
    const int tid = TID, lane = tid & 63, w = tid >> 6, wr = w >> 1, wc = w & 1, fr = lane & 15, fq = lane >> 4;
#pragma unroll
    for (int m = 0; m < 4; ++m)
#pragma unroll
        for (int n = 0; n < 4; ++n) acc[m][n] = f32x4{0.f, 0.f, 0.f, 0.f};
#pragma unroll
    for (int ks = 0; ks < 4; ++ks) {
        bf16x8 a[4], b[4];
#pragma unroll
        for (int m = 0; m < 4; ++m) a[m] = *(const bf16x8*)&Al[(wr * 64 + m * 16 + fr) * LDW + ks * 32 + fq * 8];
#pragma unroll
        for (int n = 0; n < 4; ++n) b[n] = *(const bf16x8*)&Bl[(wc * 64 + n * 16 + fr) * LDW + ks * 32 + fq * 8];
#pragma unroll
        for (int m = 0; m < 4; ++m)
#pragma unroll
            for (int n = 0; n < 4; ++n) acc[m][n] = __builtin_amdgcn_mfma_f32_16x16x32_bf16(b[n], a[m], acc[m][n], 0, 0, 0);
    }
}

DEVI bf16x8 tr_frag(const bf16_t* base, int ld, int row0, int col0, int lane) {
    const int g = lane >> 4, li = lane & 15, q = li >> 2, pp = li & 3;
    const bf16_t* a0 = base + (row0 + g * 8 + q) * ld + col0 + pp * 4;
    s16x4 lo = __builtin_amdgcn_ds_read_tr16_b64_v4i16((LAS s16x4*)a0);
    s16x4 hi = __builtin_amdgcn_ds_read_tr16_b64_v4i16((LAS s16x4*)(a0 + 4 * ld));
    return bf16x8{lo[0], lo[1], lo[2], lo[3], hi[0], hi[1], hi[2], hi[3]};
}


namespace pg8 {
constexpr int BM = 256, BK = 64, HALF = 128, HTB = HALF * BK * 2, STAGE_BYTES = 8 * HTB, NXCD = 8, WGM = 8;
__host__ __device__ __forceinline__ int lds_byte(int r, int c) { const int st = (r >> 4) * 2 + (c >> 5), rr = r & 15, cc = c & 31, ob = rr * 64 + cc * 2; return st * 1024 + (ob ^ (((ob >> 9) & 1) << 5)); }
__host__ __device__ __forceinline__ void stage_rc(int b, int& R, int& C) { const int st = b / 1024, sb = b % 1024, swz = sb ^ (((sb >> 9) & 1) << 5); R = (st >> 1) * 16 + swz / 64; C = (st & 1) * 32 + (swz % 64) / 2; }
__host__ __device__ __forceinline__ int perm32(int rho) { const int n = rho >> 4, i = rho & 15; return 8 * (i >> 2) + 4 * n + (i & 3); }
struct Unit { int pm, pn; };
struct Gemm { const bf16_t* A; const bf16_t* Bt; int M, N, K, ld; };
struct StaticOrder {
    int nM, nN, nwg, G, c;
    __device__ void init(int M, int N, int G_, int c_) { nM = M / BM; nN = N / BM; nwg = nM * nN; G = G_; c = c_; }
    __device__ bool next(int i, Unit& u) const {
        const long L = (long)i * G + c; if (L >= nwg) return false;
        int wgid = (int)L; { const int q = nwg / NXCD, r = nwg % NXCD, xcd = wgid % NXCD, off = wgid / NXCD; wgid = (xcd < r ? xcd * (q + 1) : r * (q + 1) + (xcd - r) * q) + off; }
        const int nig = WGM * nN, gid = wgid / nig, fm = gid * WGM, gsz = (nM - fm) < WGM ? (nM - fm) : WGM;
        u.pm = fm + ((wgid % nig) % gsz); u.pn = (wgid % nig) / gsz; return true;
    }
};
struct OneUnit {
    bool has; Unit u;
    __device__ bool next(int i, Unit& o) const { if (i != 0 || !has) return false; o = u; return true; }
};
template <class Epi, class Order>
__device__ __forceinline__ void gemm_phase(LAS unsigned char* lds, const Gemm g, const Order& S, const Epi& E) {
    const int tid = threadIdx.x, wid = __builtin_amdgcn_readfirstlane(tid >> 6), lane = tid & 63, wr = wid >> 2, wc = wid & 3, fr = lane & 15, fq = lane >> 4;
    const int K = g.K, nt = K / BK, LD = g.ld;
    unsigned voffA[2], voffB[2];
#pragma unroll
    for (int i = 0; i < 2; ++i) { int R, C; stage_rc(tid * 16 + i * 8192, R, C); const int Rb = (R & ~31) + perm32(R & 31);
        voffA[i] = (unsigned)(R * LD + C) * 2u; voffB[i] = (unsigned)(Rb * LD + C) * 2u; }
    const size_t kstep = (size_t)(BK * 2);
    const size_t hstep = (size_t)HALF * LD * 2;
    const size_t tstep = 2 * hstep;
    const unsigned ldsw = (unsigned)wid * 1024u;
    const int aoff = lds_byte(wr * 64 + fr, fq * 8), boff = lds_byte(wc * 32 + fr, fq * 8);
#define PG8_SA(b, h) (((b) * 2 + (h)) * HTB)
#define PG8_SB(b, h) ((4 + (b) * 2 + (h)) * HTB)
#define PG8_STAGE(bufoff, gbase, voff) do { _Pragma("unroll") for (int _i = 0; _i < 2; ++_i) \
        __builtin_amdgcn_global_load_lds((const unsigned*)((const char*)(gbase) + (voff)[_i]), (LAS unsigned*)(lds + (bufoff) + ldsw + _i * 8192), 16, 0, 0); } while (0)
#define PG8_LDA(dst, b, h) do { _Pragma("unroll") for (int m = 0; m < 4; ++m) _Pragma("unroll") for (int k = 0; k < 2; ++k) dst[m][k] = *(const LAS bf16x8*)(lds + PG8_SA(b, h) + aoff + m * 2048 + k * 1024); } while (0)
#define PG8_LDB(dst, b, h) do { _Pragma("unroll") for (int n = 0; n < 2; ++n) _Pragma("unroll") for (int k = 0; k < 2; ++k) dst[n][k] = *(const LAS bf16x8*)(lds + PG8_SB(b, h) + boff + n * 2048 + k * 1024); } while (0)
#define PG8_MMA(ai, bj, At, Bt) do { __builtin_amdgcn_s_setprio(1); _Pragma("unroll") for (int m = 0; m < 4; ++m) _Pragma("unroll") for (int n = 0; n < 2; ++n) _Pragma("unroll") for (int k = 0; k < 2; ++k) \
        acc[ai][bj][m][n] = __builtin_amdgcn_mfma_f32_16x16x32_bf16(Bt[n][k], At[m][k], acc[ai][bj][m][n], 0, 0, 0); __builtin_amdgcn_s_setprio(0); } while (0)
#define PG8_WAIT_V(n) asm volatile("s_waitcnt vmcnt(" #n ")" ::: "memory")
#define PG8_WAIT_L(n) asm volatile("s_waitcnt lgkmcnt(" #n ")" ::: "memory")
#define PG8_BAR __builtin_amdgcn_s_barrier()
#define PG8_SCHED __builtin_amdgcn_sched_barrier(0)
    Unit cur, nxt; int ui = 0;
    if (!S.next(0, cur)) return;
    f32x4 acc[2][2][4][2];
#pragma unroll
    for (int a = 0; a < 2; ++a)
#pragma unroll
        for (int b = 0; b < 2; ++b)
#pragma unroll
            for (int m = 0; m < 4; ++m)
#pragma unroll
                for (int n = 0; n < 2; ++n) acc[a][b][m][n] = (f32x4){0.f, 0.f, 0.f, 0.f};
    bf16x8 At[4][2], B0[2][2], B1[2][2];
    const char* cA = (const char*)g.A + (size_t)cur.pm * tstep; const char* cB = (const char*)g.Bt + (size_t)cur.pn * tstep;
    PG8_STAGE(PG8_SB(0, 0), cB, voffB); PG8_STAGE(PG8_SB(0, 1), cB + hstep, voffB); PG8_STAGE(PG8_SA(0, 0), cA, voffA); PG8_STAGE(PG8_SA(0, 1), cA + hstep, voffA);
    if (wr == 1) PG8_BAR;
    PG8_WAIT_V(2); PG8_BAR;
    PG8_STAGE(PG8_SB(1, 0), cB + kstep, voffB); PG8_STAGE(PG8_SA(1, 0), cA + kstep, voffA); PG8_STAGE(PG8_SB(1, 1), cB + hstep + kstep, voffB);
    PG8_WAIT_V(6); PG8_BAR;
    for (;;) {
        const bool has_next = S.next(ui + 1, nxt);
        const char* nA = has_next ? (const char*)g.A + (size_t)nxt.pm * tstep : cA; const char* nB = has_next ? (const char*)g.Bt + (size_t)nxt.pn * tstep : cB;
        for (int t = 0; t < nt; t += 2) {
            const bool last = (t == nt - 2);
            const char* a1 = cA + (size_t)(t + 1) * kstep;
            const char* a2 = last ? nA : cA + (size_t)(t + 2) * kstep; const char* b2 = last ? nB : cB + (size_t)(t + 2) * kstep;
            const char* a3 = a2 + kstep; const char* b3 = b2 + kstep;
            PG8_LDB(B0, 0, 0); PG8_LDB(B1, 0, 1); PG8_SCHED; PG8_LDA(At, 0, 0); PG8_STAGE(PG8_SA(1, 1), a1 + hstep, voffA);
            PG8_WAIT_V(8); PG8_WAIT_L(0); PG8_BAR; PG8_MMA(0, 0, At, B0); PG8_MMA(0, 1, At, B1); PG8_BAR; PG8_SCHED;
            PG8_LDA(At, 0, 1); PG8_STAGE(PG8_SB(0, 0), b2, voffB); PG8_STAGE(PG8_SB(0, 1), b2 + hstep, voffB); PG8_STAGE(PG8_SA(0, 0), a2, voffA);
            PG8_WAIT_V(8); PG8_WAIT_L(0); PG8_BAR; PG8_MMA(1, 0, At, B0); PG8_MMA(1, 1, At, B1); PG8_BAR; PG8_SCHED;
            PG8_LDB(B0, 1, 0); PG8_LDB(B1, 1, 1); PG8_SCHED; PG8_LDA(At, 1, 0); PG8_STAGE(PG8_SA(0, 1), a2 + hstep, voffA);
            PG8_WAIT_V(8); PG8_WAIT_L(0); PG8_BAR; PG8_MMA(0, 0, At, B0); PG8_MMA(0, 1, At, B1); PG8_BAR; PG8_SCHED;
            PG8_LDA(At, 1, 1); PG8_STAGE(PG8_SB(1, 0), b3, voffB); PG8_STAGE(PG8_SB(1, 1), b3 + hstep, voffB); PG8_STAGE(PG8_SA(1, 0), a3, voffA);
            PG8_WAIT_V(8); PG8_WAIT_L(0); PG8_BAR; PG8_MMA(1, 0, At, B0); PG8_MMA(1, 1, At, B1); PG8_BAR; PG8_SCHED;
        }
        if (wr == 0) PG8_BAR;
        E(acc, cur, wr, wc, fr, fq);
        if (!has_next) break;
#pragma unroll
        for (int a = 0; a < 2; ++a)
#pragma unroll
            for (int b = 0; b < 2; ++b)
#pragma unroll
                for (int m = 0; m < 4; ++m)
#pragma unroll
                    for (int n = 0; n < 2; ++n) acc[a][b][m][n] = (f32x4){0.f, 0.f, 0.f, 0.f};
        cur = nxt; cA = nA; cB = nB; ++ui;
        if (wr == 1) PG8_BAR;
    }
    PG8_WAIT_V(0);
    PG8_BAR;
#undef PG8_SA
#undef PG8_SB
#undef PG8_STAGE
#undef PG8_LDA
#undef PG8_LDB
#undef PG8_MMA
#undef PG8_WAIT_V
#undef PG8_WAIT_L
#undef PG8_BAR
#undef PG8_SCHED
}
#define PG8_ROW(u, ai, m) ((u).pm * 256 + (ai) * 128 + wr * 64 + (m) * 16 + fr)
#define PG8_COL(u, bj, n) ((u).pn * 256 + (bj) * 128 + wc * 32 + fq * 8 + (n) * 4)
}

DEVI void transpose_tile(const float* __restrict__ src, int ld, bf16_t* __restrict__ dst, int K, int k0, int n0, float* tile) {
    const int tid = TID;
    const int n = tid & 63, kq = tid >> 6;
#pragma unroll 4
    for (int i = 0; i < 16; ++i) { const int k = kq * 16 + i; tile[k * 65 + n] = src[(size_t)(k0 + k) * ld + n0 + n]; }
    __syncthreads();
    const int kp = tid & 31, nq = tid >> 5;
#pragma unroll 4
    for (int i = 0; i < 8; ++i) {
        const int nn = nq * 8 + i;
        const float a = tile[(2 * kp) * 65 + nn], b = tile[(2 * kp + 1) * 65 + nn];
        *(unsigned*)&dst[(size_t)(n0 + nn) * K + k0 + 2 * kp] = pack2(a, b);
    }
    __syncthreads();
}

DEVI void phase0(const Params& p, unsigned char* smem) {
    float* tile = (float*)(smem + VHALF * SMEM_HALF);
    unsigned char* ws = p.ws;
    const int tid = TID;
    constexpr int T_IN = 640, T_OUT = 256, T_Q = 512, T_MOD = 1536, T_POOL = 16;
    constexpr int T_ALL = T_IN + T_OUT + T_Q + T_MOD + T_POOL;
    constexpr int L_KEYS = 128, L_AMOD = 128, L_POOL = 352;
    for (int it0 = blockIdx.x * 2; it0 < T_ALL; it0 += NVB) {
        int it = it0 + VHALF;
        if (it < T_IN) { transpose_tile(p.w_in, DIN, (bf16_t*)(ws + WS_WTIN), 1024, (it / 40) * 64, (it % 40) * 64, tile); continue; }
        it -= T_IN;
        if (it < T_OUT) { transpose_tile(p.w_out, 1024, (bf16_t*)(ws + WS_WTOUT), 1024, (it / 16) * 64, (it % 16) * 64, tile); continue; }
        it -= T_OUT;
        if (it < T_Q) { transpose_tile(p.w_q, 2048, (bf16_t*)(ws + WS_WTQ), 1024, (it / 32) * 64, (it % 32) * 64, tile); continue; }
        it -= T_Q;
        if (it < T_MOD) { transpose_tile(p.w_mod, NMOD, (bf16_t*)(ws + WS_WTMOD), 1024, (it / 96) * 64, (it % 96) * 64, tile); continue; }
        it -= T_MOD;
        { const int g = it >> 2, r = it & 3; transpose_tile(p.w_pool + g * 16384, 128, (bf16_t*)(ws + WS_WTPOOL) + g * 16384, 128, (r >> 1) * 64, (r & 1) * 64, tile); }
    }
    for (int item = blockIdx.x * 2 + VHALF; item < L_KEYS + L_AMOD + L_POOL; item += NVB) {
        int it = item;
        if (it < L_KEYS) {
            const size_t e = (size_t)it * 2048 + tid * 8;
            const float4 a = *(const float4*)(p.sub_keys + e), b = *(const float4*)(p.sub_keys + e + 4);
            *(uint4*)((bf16_t*)(ws + WS_KEYS) + e) = uint4{pack2(a.x, a.y), pack2(a.z, a.w), pack2(b.x, b.y), pack2(b.z, b.w)};
            continue;
        }
        it -= L_KEYS;
        if (it < L_AMOD) {
            const int row = it * 2 + (tid >> 7), col = (tid & 127) * 8;
            uint4 o = uint4{0u, 0u, 0u, 0u};
            if (row < NSEQ) {
                const float* c = (row < 8 ? p.c_prompt + (size_t)row * D : p.c_sample + (size_t)(row - 8) * D) + col;
                const float4 a = *(const float4*)c, b = *(const float4*)(c + 4);
                float v[8] = {a.x, a.y, a.z, a.w, b.x, b.y, b.z, b.w};
#pragma unroll
                for (int j = 0; j < 8; ++j) v[j] = v[j] * sigmoidf_(v[j]);
                o = uint4{pack2(v[0], v[1]), pack2(v[2], v[3]), pack2(v[4], v[5]), pack2(v[6], v[7])};
            }
            *(uint4*)((bf16_t*)(ws + WS_AMOD) + (size_t)row * D + col) = o;
            continue;
        }
        it -= L_AMOD;
        {
            const size_t e = (size_t)it * 2048 + tid * 8;
            const int b = (int)(e / (11 * 512)), r = (int)(e % (11 * 512));
            const float* sp = p.state_pool + (size_t)b * 15 * 512 + 4 * 512 + r;
            float* d = p.out + O_POOLS + (size_t)b * 15 * 512 + r;
            *(float4*)d = *(const float4*)sp; *(float4*)(d + 4) = *(const float4*)(sp + 4);
        }
    }
}

struct EpiMod {
    float* mod; const float* bias;
    DEVI void operator()(const f32x4 (&acc)[2][2][4][2], const pg8::Unit& u, int wr, int wc, int fr, int fq) const {
        f32x4 bv[2][2];
#pragma unroll
        for (int bj = 0; bj < 2; ++bj)
#pragma unroll
            for (int n = 0; n < 2; ++n) bv[bj][n] = *(const f32x4*)(bias + PG8_COL(u, bj, n));
#pragma unroll
        for (int ai = 0; ai < 2; ++ai)
#pragma unroll
            for (int m = 0; m < 4; ++m) {
                const int row = PG8_ROW(u, ai, m);
#pragma unroll
                for (int bj = 0; bj < 2; ++bj)
#pragma unroll
                    for (int n = 0; n < 2; ++n) *(f32x4*)(mod + (size_t)row * NMOD + PG8_COL(u, bj, n)) = acc[ai][bj][m][n] + bv[bj][n];
            }
    }
};
struct EpiP {
    bf16_t* P; const float* bias; float* out;
    DEVI void operator()(const f32x4 (&acc)[2][2][4][2], const pg8::Unit& u, int wr, int wc, int fr, int fq) const {
        f32x4 bv[2][2];
#pragma unroll
        for (int bj = 0; bj < 2; ++bj)
#pragma unroll
            for (int n = 0; n < 2; ++n) bv[bj][n] = *(const f32x4*)(bias + PG8_COL(u, bj, n));
#pragma unroll
        for (int ai = 0; ai < 2; ++ai)
#pragma unroll
            for (int m = 0; m < 4; ++m) {
                const int row = PG8_ROW(u, ai, m);
                float* pool_dst = nullptr;
                if (u.pn < 2) {
                    if (row < NTP) { const int t = row & (SEQ - 1); if (t >= SEQ - 15) pool_dst = out + O_POOLP + ((size_t)(row >> 11) * 15 + (t - (SEQ - 15))) * 512; }
                    else { const int r = row - NTP; pool_dst = out + O_POOLS + ((size_t)(r >> 2) * 15 + 11 + (r & 3)) * 512; }
                }
#pragma unroll
                for (int bj = 0; bj < 2; ++bj) {
                    const int col = PG8_COL(u, bj, 0);
                    const f32x4 v0 = acc[ai][bj][m][0] + bv[bj][0], v1 = acc[ai][bj][m][1] + bv[bj][1];
                    *(u32x4*)(P + (size_t)row * NP + col) = u32x4{pack2(v0[0], v0[1]), pack2(v0[2], v0[3]), pack2(v1[0], v1[1]), pack2(v1[2], v1[3])};
                    if (pool_dst) { *(f32x4*)(pool_dst + col) = v0; *(f32x4*)(pool_dst + col + 4) = v1; }
                }
            }
    }
};
struct EpiOut {
    const float* xp; const float* xs; const float* mod; float* out;
    DEVI void operator()(const f32x4 (&acc)[2][2][4][2], const pg8::Unit& u, int wr, int wc, int fr, int fq) const {
        const float* g1 = mod + (size_t)((u.pm * 256) >> 11) * NMOD + 2048;
        f32x4 gv[2][2];
#pragma unroll
        for (int bj = 0; bj < 2; ++bj)
#pragma unroll
            for (int n = 0; n < 2; ++n) gv[bj][n] = *(const f32x4*)(g1 + PG8_COL(u, bj, n)) + 1.f;
#pragma unroll
        for (int ai = 0; ai < 2; ++ai)
#pragma unroll
            for (int bj = 0; bj < 2; ++bj) {
                f32x4 xv[4][2];
#pragma unroll
                for (int m = 0; m < 4; ++m)
#pragma unroll
                    for (int n = 0; n < 2; ++n) xv[m][n] = *(const f32x4*)(xp + (size_t)PG8_ROW(u, ai, m) * D + PG8_COL(u, bj, n));
#pragma unroll
                for (int m = 0; m < 4; ++m)
#pragma unroll
                    for (int n = 0; n < 2; ++n) *(f32x4*)(out + (size_t)PG8_ROW(u, ai, m) * D + PG8_COL(u, bj, n)) = xv[m][n] * ALPHA + gv[bj][n] * acc[ai][bj][m][n];
            }
    }
};
struct EpiQ {
    bf16_t* Q;
    DEVI void operator()(const f32x4 (&acc)[2][2][4][2], const pg8::Unit& u, int wr, int wc, int fr, int fq) const {
#pragma unroll
        for (int ai = 0; ai < 2; ++ai)
#pragma unroll
            for (int m = 0; m < 4; ++m) {
                const int row = PG8_ROW(u, ai, m);
#pragma unroll
                for (int bj = 0; bj < 2; ++bj) {
                    const int col = PG8_COL(u, bj, 0);
                    const f32x4 v0 = acc[ai][bj][m][0] * 1.f, v1 = acc[ai][bj][m][1] * 1.f;
                    *(u32x4*)(Q + (size_t)row * 2048 + col) = u32x4{pack2(v0[0], v0[1]), pack2(v0[2], v0[3]), pack2(v1[0], v1[1]), pack2(v1[2], v1[3])};
                }
            }
    }
};

DEVI void phase1(const Params& p, unsigned char* smem) {
    unsigned char* ws = p.ws;
    {
        pg8::Gemm g{(const bf16_t*)(ws + WS_AMOD), (const bf16_t*)(ws + WS_WTMOD), 256, NMOD, D, D};
        pg8::StaticOrder S; S.init(256, NMOD, (int)gridDim.x, (int)blockIdx.x);
        EpiMod E{(float*)(ws + WS_MOD), p.b_mod};
        pg8::gemm_phase(( LAS unsigned char*)smem, g, S, E);
    }
    const int tid = TID, lane = tid & 63, w = tid >> 6;
    {
        for (int ci = ((int)blockIdx.x - 24) * 2 + VHALF; ci >= 0 && ci < 4096; ci += NVB - 48) {
            {
            const bool isu = ci < 2048;
            const int row0 = (ci & 2047) * 8 + w * 2;
            const float* tab = isu ? p.u_tab : p.v_tab;
            unsigned char* dst = ws + (isu ? WS_UT : WS_VT);
            float* sc = (float*)(ws + (isu ? WS_USC : WS_VSC));
#pragma unroll
            for (int r = 0; r < 2; ++r) {
                const int row = row0 + r;
                const float* src = tab + (size_t)row * D + lane * 16;
                float v[16];
#pragma unroll
                for (int i = 0; i < 4; ++i) { const float4 t = *(const float4*)(src + i * 4); v[i * 4] = t.x; v[i * 4 + 1] = t.y; v[i * 4 + 2] = t.z; v[i * 4 + 3] = t.w; }
                float am = 0.f;
#pragma unroll
                for (int i = 0; i < 16; ++i) am = fmaxf(am, fabsf(v[i]));
#pragma unroll
                for (int o = 32; o > 0; o >>= 1) am = fmaxf(am, __shfl_xor(am, o));
                if (isu && !UFP4) {
                    const float scl = am > 0.f ? 224.f / am : 1.f;
                    if (lane == 0) sc[row] = am > 0.f ? am * (1.f / 224.f) : 1.f;
                    int wd[4];
#pragma unroll
                    for (int i = 0; i < 4; ++i) {
                        int t = __builtin_amdgcn_cvt_pk_fp8_f32(v[i * 4] * scl, v[i * 4 + 1] * scl, 0, false);
                        wd[i] = __builtin_amdgcn_cvt_pk_fp8_f32(v[i * 4 + 2] * scl, v[i * 4 + 3] * scl, t, true);
                    }
                    *(int4*)(dst + (size_t)row * D + lane * 16) = int4{wd[0], wd[1], wd[2], wd[3]};
                } else {
                    const float scl = am > 0.f ? 6.f / am : 1.f;
                    if (lane == 0) sc[row] = am > 0.f ? am * (1.f / 6.f) : 1.f;
                    unsigned d0 = 0u, d1 = 0u;
                    d0 = __builtin_amdgcn_cvt_scalef32_pk_fp4_f32(d0, v[0] * scl, v[1] * scl, 1.0f, 0);
                    d0 = __builtin_amdgcn_cvt_scalef32_pk_fp4_f32(d0, v[2] * scl, v[3] * scl, 1.0f, 1);
                    d0 = __builtin_amdgcn_cvt_scalef32_pk_fp4_f32(d0, v[4] * scl, v[5] * scl, 1.0f, 2);
                    d0 = __builtin_amdgcn_cvt_scalef32_pk_fp4_f32(d0, v[6] * scl, v[7] * scl, 1.0f, 3);
                    d1 = __builtin_amdgcn_cvt_scalef32_pk_fp4_f32(d1, v[8] * scl, v[9] * scl, 1.0f, 0);
                    d1 = __builtin_amdgcn_cvt_scalef32_pk_fp4_f32(d1, v[10] * scl, v[11] * scl, 1.0f, 1);
                    d1 = __builtin_amdgcn_cvt_scalef32_pk_fp4_f32(d1, v[12] * scl, v[13] * scl, 1.0f, 2);
                    d1 = __builtin_amdgcn_cvt_scalef32_pk_fp4_f32(d1, v[14] * scl, v[15] * scl, 1.0f, 3);
                    *(uint2*)(dst + (size_t)row * 512 + lane * 8) = uint2{d0, d1};
                }
            }
        }
    }
    }
}

DEVI void phase2(const Params& p, unsigned char* smem) {
    unsigned char* ws = p.ws;
    const int tid = threadIdx.x, lane = tid & 63, w = tid >> 6;
    const float* mod = (const float*)(ws + WS_MOD);
    bf16_t* u1 = (bf16_t*)(ws + WS_BUFA);
    float* gates = (float*)(ws + WS_GATES);
    float* Wg = (float*)smem;
    for (int k = tid; k < 1024; k += 512) {
        const float4 w0 = *(const float4*)(p.w_in + (size_t)k * DIN + NP), w1 = *(const float4*)(p.w_in + (size_t)k * DIN + NP + 4);
        Wg[k] = w0.x; Wg[1024 + k] = w0.y; Wg[2048 + k] = w0.z; Wg[3072 + k] = w0.w;
        Wg[4096 + k] = w1.x; Wg[5120 + k] = w1.y; Wg[6144 + k] = w1.z; Wg[7168 + k] = w1.w;
    }
    __syncthreads();
    const int nw = gridDim.x * 8;
    for (int tok0 = blockIdx.x * 8 + w; tok0 < NT; tok0 += 2 * nw) {
      float vv[2][16];
      const bool has2 = tok0 + nw < NT;
#pragma unroll
      for (int t = 0; t < 2; ++t) {
          const float* x = xrow_ptr(p, (t == 0 || has2) ? tok0 + t * nw : tok0);
#pragma unroll
          for (int i = 0; i < 4; ++i) { const float4 q4 = *(const float4*)(x + i * 256 + lane * 4); vv[t][i * 4] = q4.x; vv[t][i * 4 + 1] = q4.y; vv[t][i * 4 + 2] = q4.z; vv[t][i * 4 + 3] = q4.w; }
      }
#pragma unroll
      for (int t = 0; t < 2; ++t) {
        if (t == 1 && !has2) break;
        const int tok = tok0 + t * nw;
        const float* ms = mod + (size_t)seq_of(tok) * NMOD;
        float v[16];
#pragma unroll
        for (int i = 0; i < 16; ++i) v[i] = vv[t][i];
        float s = 0.f;
#pragma unroll
        for (int i = 0; i < 16; ++i) s += v[i];
        const float mean = wave_sum(s) * (1.f / 1024.f);
        float q = 0.f;
#pragma unroll
        for (int i = 0; i < 16; ++i) { v[i] -= mean; q += v[i] * v[i]; }
        const float rstd = rsqrtf(wave_sum(q) * (1.f / 1024.f) + LN_EPS);
        float g[8] = {0.f, 0.f, 0.f, 0.f, 0.f, 0.f, 0.f, 0.f};
#pragma unroll
        for (int i = 0; i < 4; ++i) {
            const int c = i * 256 + lane * 4;
            const float4 sh = *(const float4*)(ms + c), sc = *(const float4*)(ms + 1024 + c);
            float u[4];
            u[0] = v[i * 4] * rstd * (1.f + sc.x) + sh.x; u[1] = v[i * 4 + 1] * rstd * (1.f + sc.y) + sh.y;
            u[2] = v[i * 4 + 2] * rstd * (1.f + sc.z) + sh.z; u[3] = v[i * 4 + 3] * rstd * (1.f + sc.w) + sh.w;
            *(uint2*)(u1 + (size_t)tok * D + c) = uint2{pack2(u[0], u[1]), pack2(u[2], u[3])};
#pragma unroll
            for (int gg = 0; gg < 8; ++gg) {
                const float4 wv = *(const float4*)&Wg[gg * 1024 + c];
                g[gg] += u[0] * wv.x + u[1] * wv.y + u[2] * wv.z + u[3] * wv.w;
            }
        }
#pragma unroll
        for (int j = 0; j < 8; ++j) g[j] = wave_sum(g[j]);
        if (lane == 0) {
            const float4 b0 = *(const float4*)(p.b_in + NP), b1 = *(const float4*)(p.b_in + NP + 4);
            *(float4*)(gates + (size_t)tok * 8) = float4{g[0] + b0.x, g[1] + b0.y, g[2] + b0.z, g[3] + b0.w};
            *(float4*)(gates + (size_t)tok * 8 + 4) = float4{g[4] + b1.x, g[5] + b1.y, g[6] + b1.z, g[7] + b1.w};
        }
      }
    }
}

DEVI void phase3(const Params& p, unsigned char* smem) {
    unsigned char* ws = p.ws;
    const int lane = threadIdx.x & 63;
    pg8::Gemm g{(const bf16_t*)(ws + WS_BUFA), (const bf16_t*)(ws + WS_WTIN), NT, NP, D, D};
    pg8::StaticOrder S; S.init(NT, NP, (int)gridDim.x, (int)blockIdx.x);
    EpiP E{(bf16_t*)(ws + WS_P), p.b_in, p.out};
    pg8::gemm_phase((LAS unsigned char*)smem, g, S, E);
    if ((int)blockIdx.x >= (int)gridDim.x - 32 && (threadIdx.x >> 6) == 0) {
        const int bh = (int)blockIdx.x - ((int)gridDim.x - 32), b = bh >> 2, h = bh & 3;
        const float* gates = (const float*)(ws + WS_GATES);
        float* mst = (float*)(ws + WS_MST) + bh * 64;
        float m = 0.f;
        for (int c = 0; c < 32; ++c) {
            const int tok = b * SEQ + c * 64 + lane;
            const float gi = gates[(size_t)tok * 8 + h], gf = gates[(size_t)tok * 8 + 4 + h];
            const float bb = scan_sum_incl(logsigmoid(gf), lane);
            const float R = scan_max_incl(gi - bb, lane);
            const float B63 = __shfl(bb, 63), R63 = __shfl(R, 63);
            {
                const int ti = bh * 2048 + c * 64 + lane;
                ((float*)(ws + WS_GA))[ti] = B63 - bb + gi; ((float*)(ws + WS_BB))[ti] = bb;
                ((float*)(ws + WS_RR))[ti] = gi - bb; ((float*)(ws + WS_RPM))[ti] = R;
                if (lane == 0) ((float*)(ws + WS_BCH))[bh * 32 + c] = B63;
            }
            if (lane == 0) mst[c] = m;
            m = B63 + fmaxf(m, R63);
        }
        if (lane == 0) { mst[32] = m; p.out[O_MP + bh] = m; }
    }
}

#define LDS_BAR() do { asm volatile("s_waitcnt lgkmcnt(0)" ::: "memory"); __builtin_amdgcn_s_barrier(); asm volatile("" ::: "memory"); } while (0)
DEVI void p4_state_scan(const Params& p, unsigned char* smem, int it) {
    unsigned char* ws = p.ws;
    const int tid = TID, lane = tid & 63, w = tid >> 6, fr = lane & 15, fq = lane >> 4;
    const int bh = it >> 3, sl = it & 7, b = bh >> 2, h = bh & 3;
    bf16_t* Ks = (bf16_t*)smem;
    bf16_t* Vs = (bf16_t*)(smem + 64 * LDW * 2);
    float* gin = (float*)(smem + 64 * LDW * 2 + 64 * 24 * 2);
    const bf16_t* P = (const bf16_t*)(ws + WS_P);
    const float* gates = (const float*)(ws + WS_GATES);
    const float* mst = (const float*)(ws + WS_MST) + bh * 64;
    bf16_t* ST = (bf16_t*)(ws + WS_BUFB) + (size_t)bh * 32 * 16384;
    float* nst = (float*)(ws + WS_NST) + (size_t)bh * 32 * 128;
    f32x4 acc[2] = {f32x4{0.f, 0.f, 0.f, 0.f}, f32x4{0.f, 0.f, 0.f, 0.f}};
    float nacc = 0.f;
    u32x4 ka0, ka1, ka2, ka3, va = u32x4{0u, 0u, 0u, 0u}; float gia = 0.f, gfa = 0.f;
    u32x4 kb0, kb1, kb2, kb3, vb_ = u32x4{0u, 0u, 0u, 0u}; float gib = 0.f, gfb = 0.f;
    const int ks_ = tid >> 4, kc_ = tid & 15;
#define P4_PREFETCH(c, K0, K1, K2, K3, VR, GI, GF) do { const int _t0 = b * SEQ + (c) * 64; \
        { const bf16_t* _kp = P + (size_t)(_t0 + ks_) * NP + 1024 + h * 128 + kc_ * 8; \
          K0 = *(const u32x4*)(_kp); K1 = *(const u32x4*)(_kp + (size_t)16 * NP); K2 = *(const u32x4*)(_kp + (size_t)32 * NP); K3 = *(const u32x4*)(_kp + (size_t)48 * NP); } \
        if (tid < 128) VR = *(const u32x4*)(P + (size_t)(_t0 + (tid >> 1)) * NP + 1536 + h * 128 + sl * 16 + (tid & 1) * 8); \
        if (w == 0) { GI = ((const float*)(ws + WS_GA))[bh * 2048 + (c) * 64 + lane]; GF = ((const float*)(ws + WS_BCH))[bh * 32 + (c)]; } } while (0)
#define P4_STEP(c, K0, K1, K2, K3, VR, GI, GF) do { \
        if (w == 0) { \
            const float mc = mst[(c)], mn = mst[(c) + 1]; \
            gin[lane] = expf(GI - mn) * KSCALE; \
            if (lane == 0) gin[64] = expf(GF + mc - mn); \
        } \
        *(u32x4*)&Ks[ks_ * LDW + kc_ * 8] = K0; *(u32x4*)&Ks[(ks_ + 16) * LDW + kc_ * 8] = K1; \
        *(u32x4*)&Ks[(ks_ + 32) * LDW + kc_ * 8] = K2; *(u32x4*)&Ks[(ks_ + 48) * LDW + kc_ * 8] = K3; \
        const u32x4 v = VR; \
        LDS_BAR(); \
        if ((c) + 2 < 32) P4_PREFETCH((c) + 2, K0, K1, K2, K3, VR, GI, GF); \
        { \
            bf16_t* STc = ST + (size_t)(c) * 16384; \
            _Pragma("unroll") for (int mt = 0; mt < 2; ++mt) { \
                const int d0 = (w * 2 + mt) * 16 + fq * 4, e = sl * 16 + fr; \
                *(uint2*)(STc + e * 128 + d0) = uint2{pack2(acc[mt][0], acc[mt][1]), pack2(acc[mt][2], acc[mt][3])}; \
            } \
            if (w == 0 && lane < 16) nst[(c) * 128 + sl * 16 + lane] = nacc; \
        } \
        const float gprev = gin[64]; \
        if (tid < 128) { \
            const int s_ = tid >> 1, hf = tid & 1; \
            const float g = gin[s_]; \
            *(uint4*)&Vs[s_ * 24 + hf * 8] = uint4{pack2(bf_lo(v.x) * g, bf_hi(v.x) * g), pack2(bf_lo(v.y) * g, bf_hi(v.y) * g), \
                                                    pack2(bf_lo(v.z) * g, bf_hi(v.z) * g), pack2(bf_lo(v.w) * g, bf_hi(v.w) * g)}; \
        } \
        if (w == 0) { \
            const int d = sl * 16 + fr; \
            float a = 0.f; \
            _Pragma("unroll") for (int s_ = 0; s_ < 16; ++s_) a += bf1(Ks[(fq * 16 + s_) * LDW + d]) * gin[fq * 16 + s_]; \
            nacc = gprev * nacc + sumq(a); \
        } \
        LDS_BAR(); \
        _Pragma("unroll") for (int mt = 0; mt < 2; ++mt) { acc[mt][0] *= gprev; acc[mt][1] *= gprev; acc[mt][2] *= gprev; acc[mt][3] *= gprev; } \
        _Pragma("unroll") for (int ks = 0; ks < 2; ++ks) { \
            const bf16x8 vfr = tr_frag(Vs, 24, ks * 32, 0, lane); \
            _Pragma("unroll") for (int mt = 0; mt < 2; ++mt) { \
                const bf16x8 ka = tr_frag(Ks, LDW, ks * 32, (w * 2 + mt) * 16, lane); \
                acc[mt] = __builtin_amdgcn_mfma_f32_16x16x32_bf16(ka, vfr, acc[mt], 0, 0, 0); \
            } \
        } \
        LDS_BAR(); } while (0)
    P4_PREFETCH(0, ka0, ka1, ka2, ka3, va, gia, gfa);
    P4_PREFETCH(1, kb0, kb1, kb2, kb3, vb_, gib, gfb);
    for (int c = 0; c < 32; c += 2) {
        P4_STEP(c, ka0, ka1, ka2, ka3, va, gia, gfa);
        P4_STEP(c + 1, kb0, kb1, kb2, kb3, vb_, gib, gfb);
    }
#undef P4_STEP
#undef P4_PREFETCH
    float* Cp = p.out + O_CP + (size_t)bh * 16384;
#pragma unroll
    for (int mt = 0; mt < 2; ++mt)
#pragma unroll
        for (int j = 0; j < 4; ++j) Cp[((w * 2 + mt) * 16 + fq * 4 + j) * 128 + sl * 16 + fr] = acc[mt][j];
    if (w == 0 && lane < 16) p.out[O_NP + bh * 128 + sl * 16 + lane] = nacc;
}

DEVI void p4_sample(const Params& p, unsigned char* smem, int it) {
    unsigned char* ws = p.ws;
    const int tid = TID, lane = tid & 63, w = tid >> 6;
    const int b = it >> 2, h = it & 3;
    float* qs = (float*)smem;
    float* kg = qs + 512;
    float* vs = kg + 512;
    float* ksc = vs + 512;
    float* qS = ksc + 512;
    float* Pm = qS + 1024;
    float* qn = Pm + 16;
    const bf16_t* P = (const bf16_t*)(ws + WS_P);
    const float* gates = (const float*)(ws + WS_GATES);
    const int tok0 = NTP + b * 4;
    float gi[4], bb[4], mt_[4];
    const float m0 = p.state_m[b * 4 + h];
    {
        float cum = 0.f, R = -INFINITY;
#pragma unroll
        for (int s = 0; s < 4; ++s) {
            gi[s] = gates[(size_t)(tok0 + s) * 8 + h];
            cum += logsigmoid(gates[(size_t)(tok0 + s) * 8 + 4 + h]);
            bb[s] = cum; R = fmaxf(R, gi[s] - cum);
            mt_[s] = cum + fmaxf(m0, R);
        }
    }
    const float mnew = mt_[3];
    const float gprev = expf(bb[3] + m0 - mnew);
    float gin[4];
#pragma unroll
    for (int s = 0; s < 4; ++s) gin[s] = expf(bb[3] - bb[s] + gi[s] - mnew);
    {
        const int t = tid >> 6, dd = (tid & 63) * 2;
        const bf16_t* row = P + (size_t)(tok0 + t) * NP + h * 128 + dd;
        const unsigned uq = *(const unsigned*)(row + 512), uk = *(const unsigned*)(row + 1024), uv = *(const unsigned*)(row + 1536);
        float g = gin[0]; g = t == 1 ? gin[1] : g; g = t == 2 ? gin[2] : g; g = t == 3 ? gin[3] : g;
        qs[t * 128 + dd] = bf_lo(uq); qs[t * 128 + dd + 1] = bf_hi(uq);
        const float k0 = bf_lo(uk) * KSCALE, k1 = bf_hi(uk) * KSCALE;
        ksc[t * 128 + dd] = k0; ksc[t * 128 + dd + 1] = k1;
        kg[t * 128 + dd] = k0 * g; kg[t * 128 + dd + 1] = k1 * g;
        vs[t * 128 + dd] = bf_lo(uv); vs[t * 128 + dd + 1] = bf_hi(uv);
    }
    __syncthreads();
    const int e = tid & 127, dh = tid >> 7;
    const float* S0 = p.state_C + (size_t)(b * 4 + h) * 16384;
    float* Cs = p.out + O_CS + (size_t)(b * 4 + h) * 16384;
    const float v0 = vs[e], v1 = vs[128 + e], v2 = vs[256 + e], v3 = vs[384 + e];
    float a0 = 0.f, a1 = 0.f, a2 = 0.f, a3 = 0.f;
    for (int hh = 0; hh < 4; ++hh) {
    float Sv[16];
#pragma unroll
    for (int i = 0; i < 16; ++i) Sv[i] = S0[(dh * 64 + hh * 16 + i) * 128 + e];
#pragma unroll
    for (int i = 0; i < 16; ++i) {
        const int d = dh * 64 + hh * 16 + i;
        const float S = Sv[i];
        a0 += qs[d] * S; a1 += qs[128 + d] * S; a2 += qs[256 + d] * S; a3 += qs[384 + d] * S;
        Cs[d * 128 + e] = gprev * S + kg[d] * v0 + kg[128 + d] * v1 + kg[256 + d] * v2 + kg[384 + d] * v3;
    }
    }
    qS[(dh * 4 + 0) * 128 + e] = a0; qS[(dh * 4 + 1) * 128 + e] = a1; qS[(dh * 4 + 2) * 128 + e] = a2; qS[(dh * 4 + 3) * 128 + e] = a3;
    {
        const int t = w;
        const float* n0 = p.state_n + (size_t)(b * 4 + h) * 128;
        const float q0 = qs[t * 128 + lane], q1 = qs[t * 128 + 64 + lane];
        const float qn_ = wave_sum(q0 * n0[lane] + q1 * n0[64 + lane]);
        if (lane == 0) qn[t] = qn_;
#pragma unroll
        for (int s = 0; s < 4; ++s) {
            const float d = wave_sum(q0 * ksc[s * 128 + lane] + q1 * ksc[s * 128 + 64 + lane]);
            if (lane == 0) Pm[t * 4 + s] = (s <= t) ? d * expf(bb[t] - bb[s] + gi[s] - mt_[t]) : 0.f;
        }
        if (t == 0) {
            const float n_a = gprev * n0[lane] + kg[lane] + kg[128 + lane] + kg[256 + lane] + kg[384 + lane];
            const float n_b = gprev * n0[64 + lane] + kg[64 + lane] + kg[192 + lane] + kg[320 + lane] + kg[448 + lane];
            p.out[O_NS + (size_t)(b * 4 + h) * 128 + lane] = n_a;
            p.out[O_NS + (size_t)(b * 4 + h) * 128 + 64 + lane] = n_b;
            if (lane == 0) p.out[O_MS + b * 4 + h] = mnew;
        }
    }
    __syncthreads();
    {
        const int t = w;
        const float wprev = expf(bb[t] + m0 - mt_[t]);
        const float p0 = Pm[t * 4], p1 = Pm[t * 4 + 1], p2 = Pm[t * 4 + 2], p3 = Pm[t * 4 + 3];
        const float den = wprev * qn[t] + p0 + p1 + p2 + p3;
        const float inv = 1.f / fmaxf(fabsf(den), expf(-mt_[t]));
        float hv[2];
#pragma unroll
        for (int r = 0; r < 2; ++r) {
            const int ee = lane + 64 * r;
            const float num = wprev * (qS[t * 128 + ee] + qS[(4 + t) * 128 + ee]) + p0 * vs[ee] + p1 * vs[128 + ee] + p2 * vs[256 + ee] + p3 * vs[384 + ee];
            hv[r] = num * inv;
        }
        const float mean = wave_sum(hv[0] + hv[1]) * (1.f / 128.f);
        const float c0 = hv[0] - mean, c1 = hv[1] - mean;
        const float rstd = rsqrtf(wave_sum(c0 * c0 + c1 * c1) * (1.f / 128.f) + LN_EPS);
        bf16_t* ym = (bf16_t*)(ws + WS_BUFA) + (size_t)(tok0 + t) * D + 512 + h * 128;
        const bf16_t* orow = P + (size_t)(tok0 + t) * NP + 2048 + h * 128;
#pragma unroll
        for (int r = 0; r < 2; ++r) {
            const int ee = lane + 64 * r;
            const float y = (r ? c1 : c0) * rstd * p.mh_norm_g[h * 128 + ee] * sigmoidf_(bf1(orow[ee]));
            ym[ee] = (bf16_t)(pack2(y, 0.f) & 0xFFFFu);
        }
    }
    __syncthreads();
}

DEVI void p4_pool(const Params& p, unsigned char* smem, int it) {
    unsigned char* ws = p.ws;
    const int tid = TID, lane = tid & 63, w = tid >> 6, wr = w >> 1, wc = w & 1, fr = lane & 15, fq = lane >> 4;
    const int tt = it >> 2, g = it & 3, win = 2 << g;
    bf16_t* Ad = (bf16_t*)smem;
    bf16_t* Bw = (bf16_t*)(smem + 128 * LDW * 2);
    const bf16_t* P = (const bf16_t*)(ws + WS_P);
#pragma unroll
    for (int i = 0; i < 8; ++i) {
        const int ch = tid + i * 256, r = ch >> 4, kc = ch & 15;
        *(uint4*)&Bw[r * LDW + kc * 8] = *(const uint4*)((const bf16_t*)(ws + WS_WTPOOL) + g * 16384 + r * 128 + kc * 8);
    }
    const int c4 = (tid & 31) * 4;
    if (tt < 128) {
        const int r0 = (tid >> 5) * 16;
        const int tokb = tt * 128 + r0;
        const int t0 = tokb & (SEQ - 1);
        const bf16_t* col = P + g * 128 + c4;
        float s0 = 0.f, s1 = 0.f, s2 = 0.f, s3 = 0.f;
        {
            uint2 zh[15];
#pragma unroll
            for (int k = 1; k < 16; ++k) zh[k - 1] = (k < win && t0 - k >= 0) ? *(const uint2*)(col + (size_t)(tokb - k) * NP) : uint2{0u, 0u};
#pragma unroll
            for (int k = 0; k < 15; ++k) { s0 += bf_lo(zh[k].x); s1 += bf_hi(zh[k].x); s2 += bf_lo(zh[k].y); s3 += bf_hi(zh[k].y); }
        }
        for (int hp = 0; hp < 2; ++hp) {
            uint2 zz[8], zo[8];
#pragma unroll
            for (int i = 0; i < 8; ++i) {
                const int ii = hp * 8 + i;
                zz[i] = *(const uint2*)(col + (size_t)(tokb + ii) * NP);
                zo[i] = (t0 + ii - win + 1 >= 0) ? *(const uint2*)(col + (size_t)(tokb + ii - win + 1) * NP) : uint2{0u, 0u};
            }
#pragma unroll
            for (int i = 0; i < 8; ++i) {
                const int ii = hp * 8 + i, t = t0 + ii;
                const float u0 = bf_lo(zz[i].x), u1 = bf_hi(zz[i].x), u2 = bf_lo(zz[i].y), u3 = bf_hi(zz[i].y);
                s0 += u0; s1 += u1; s2 += u2; s3 += u3;
                const float ic = 1.f / (float)min(t + 1, win);
                *(uint2*)&Ad[(r0 + ii) * LDW + c4] = uint2{pack2(s0 * ic - u0, s1 * ic - u1), pack2(s2 * ic - u2, s3 * ic - u3)};
                s0 -= bf_lo(zo[i].x); s1 -= bf_hi(zo[i].x); s2 -= bf_lo(zo[i].y); s3 -= bf_hi(zo[i].y);
            }
        }
    } else {
        const float ic = 1.f / (float)win;
        for (int i = 0; i < 4; ++i) {
            const int sq = (tid >> 5) * 4 + i;
            const int b = (tt - 128) * 32 + sq;
            const float* buf = p.state_pool + (size_t)b * 15 * 512 + g * 128 + c4;
            const bf16_t* col = P + (size_t)(NTP + b * 4) * NP + g * 128 + c4;
            float s0 = 0.f, s1 = 0.f, s2 = 0.f, s3 = 0.f;
            for (int k = 1; k < win; ++k) { const float4 z = *(const float4*)(buf + (15 - k) * 512); s0 += z.x; s1 += z.y; s2 += z.z; s3 += z.w; }
            for (int t = 0; t < 4; ++t) {
                const uint2 z = *(const uint2*)(col + (size_t)t * NP);
                const float u0 = bf_lo(z.x), u1 = bf_hi(z.x), u2 = bf_lo(z.y), u3 = bf_hi(z.y);
                s0 += u0; s1 += u1; s2 += u2; s3 += u3;
                *(uint2*)&Ad[(sq * 4 + t) * LDW + c4] = uint2{pack2(s0 * ic - u0, s1 * ic - u1), pack2(s2 * ic - u2, s3 * ic - u3)};
                const int zi = 15 + t - win + 1;
                if (zi < 15) { const float4 zo = *(const float4*)(buf + zi * 512); s0 -= zo.x; s1 -= zo.y; s2 -= zo.z; s3 -= zo.w; }
                else { const uint2 zo = *(const uint2*)(col + (size_t)(zi - 15) * NP); s0 -= bf_lo(zo.x); s1 -= bf_hi(zo.x); s2 -= bf_lo(zo.y); s3 -= bf_hi(zo.y); }
            }
        }
    }
    __syncthreads();
    f32x4 acc[4][4];
    mma_lds128(Ad, Bw, acc);
    bf16_t* ym = (bf16_t*)(ws + WS_BUFA);
#pragma unroll
    for (int m = 0; m < 4; ++m) {
        const int row = tt * 128 + wr * 64 + m * 16 + fr;
#pragma unroll
        for (int n = 0; n < 4; ++n) {
            const int col = g * 128 + wc * 64 + n * 16 + fq * 4;
            const float4 ps = *(const float4*)(p.pool_scale + col);
            *(uint2*)(ym + (size_t)row * D + col) = uint2{pack2(acc[m][n][0] * ps.x, acc[m][n][1] * ps.y), pack2(acc[m][n][2] * ps.z, acc[m][n][3] * ps.w)};
        }
    }
    __syncthreads();
}

DEVI void phase4(const Params& p, unsigned char* smem_all) {
    unsigned char* smem = smem_all + VHALF * SMEM_HALF;
    for (int it0 = (int)blockIdx.x * 2; it0 < 512; it0 += NVB) p4_sample(p, smem, it0 + VHALF);
    const int nscan = min(128, (int)gridDim.x / 2);
    if ((int)blockIdx.x < nscan) { for (int it0 = (int)blockIdx.x * 2; it0 < 256; it0 += nscan * 2) p4_state_scan(p, smem, it0 + VHALF); return; }
    const int rb = (int)blockIdx.x - nscan, nrb = ((int)gridDim.x - nscan) * 2;
    for (int it0 = rb * 2; it0 < 528; it0 += nrb) p4_pool(p, smem, it0 + VHALF);
}

DEVI void phase5(const Params& p, unsigned char* smem_all) {
    unsigned char* smem = smem_all + VHALF * SMEM_HALF;
    unsigned char* ws = p.ws;
    const int tid = TID, lane = tid & 63, w = tid >> 6, fr = lane & 15, fq = lane >> 4;
    bf16_t* Ks = (bf16_t*)smem;
    bf16_t* Vs = (bf16_t*)(smem + 64 * LDW * 2);
    bf16_t* Ps = (bf16_t*)(smem + 2 * 64 * LDW * 2) + w * 16 * LDT;
    const bf16_t* P = (const bf16_t*)(ws + WS_P);
    const float* gates = (const float*)(ws + WS_GATES);
    for (int it0 = blockIdx.x * 2; it0 < 1024; it0 += NVB) {
        const int item = it0 + VHALF;
        const int bh = item >> 5, c = item & 31, b = bh >> 2, h = bh & 3;
        const int tok0 = b * SEQ + c * 64;
        const float gi = gates[(size_t)(tok0 + lane) * 8 + h], gf = gates[(size_t)(tok0 + lane) * 8 + 4 + h];
        const float bb = scan_sum_incl(logsigmoid(gf), lane);
        const float rr = gi - bb;
        const float R = scan_max_incl(rr, lane);
        const float mc = ((const float*)(ws + WS_MST))[bh * 64 + c];
        const float mt_all = bb + fmaxf(mc, R);
        const int trow = w * 16 + fr;
        const float bt = __shfl(bb, trow), mt = __shfl(mt_all, trow);
#pragma unroll
        for (int i = 0; i < 4; ++i) {
            const int ch = tid + i * 256, s = ch >> 4, kc = ch & 15;
            const bf16_t* src = P + (size_t)(tok0 + s) * NP + h * 128 + kc * 8;
            *(uint4*)&Ks[s * LDW + kc * 8] = *(const uint4*)(src + 1024);
            *(uint4*)&Vs[s * LDW + kc * 8] = *(const uint4*)(src + 1536);
        }
        bf16x8 qa[4];
        const bf16_t* qrow = P + (size_t)(tok0 + trow) * NP + 512 + h * 128 + fq * 8;
#pragma unroll
        for (int ks = 0; ks < 4; ++ks) qa[ks] = *(const bf16x8*)(qrow + ks * 32);
        __syncthreads();
        f32x4 sacc[4];
#pragma unroll
        for (int nt = 0; nt < 4; ++nt) {
            sacc[nt] = f32x4{0.f, 0.f, 0.f, 0.f};
#pragma unroll
            for (int ks = 0; ks < 4; ++ks) {
                const bf16x8 kb = *(const bf16x8*)&Ks[(nt * 16 + fr) * LDW + ks * 32 + fq * 8];
                sacc[nt] = __builtin_amdgcn_mfma_f32_16x16x32_bf16(kb, qa[ks], sacc[nt], 0, 0, 0);
            }
        }
        float rowsum = 0.f;
#pragma unroll
        for (int nt = 0; nt < 4; ++nt) {
            float pv[4];
#pragma unroll
            for (int j = 0; j < 4; ++j) {
                const int s = nt * 16 + fq * 4 + j;
                const float rs = __shfl(rr, s);
                const float dd = (s <= trow) ? expf(bt - mt + rs) : 0.f;
                pv[j] = sacc[nt][j] * KSCALE * dd;
                rowsum += pv[j];
            }
            *(uint2*)&Ps[fr * LDT + nt * 16 + fq * 4] = uint2{pack2(pv[0], pv[1]), pack2(pv[2], pv[3])};
        }
        rowsum = sumq(rowsum);
        float qn = 0.f;
        {
            const float* nc = (const float*)(ws + WS_NST) + (size_t)(bh * 32 + c) * 128 + fq * 8;
#pragma unroll
            for (int ks = 0; ks < 4; ++ks) {
                const float4 n0 = *(const float4*)(nc + ks * 32), n1 = *(const float4*)(nc + ks * 32 + 4);
                const u32x4 qq = __builtin_bit_cast(u32x4, qa[ks]);
                qn += bf_lo(qq.x) * n0.x + bf_hi(qq.x) * n0.y + bf_lo(qq.y) * n0.z + bf_hi(qq.y) * n0.w
                    + bf_lo(qq.z) * n1.x + bf_hi(qq.z) * n1.y + bf_lo(qq.w) * n1.z + bf_hi(qq.w) * n1.w;
            }
            qn = sumq(qn);
        }
        f32x4 oacc[8];
        const bf16_t* STc = (const bf16_t*)(ws + WS_BUFB) + (size_t)(bh * 32 + c) * 16384;
#pragma unroll
        for (int nt = 0; nt < 8; ++nt) {
            oacc[nt] = f32x4{0.f, 0.f, 0.f, 0.f};
#pragma unroll
            for (int ks = 0; ks < 4; ++ks) {
                const bf16x8 sb = *(const bf16x8*)(STc + (nt * 16 + fr) * 128 + ks * 32 + fq * 8);
                oacc[nt] = __builtin_amdgcn_mfma_f32_16x16x32_bf16(sb, qa[ks], oacc[nt], 0, 0, 0);
            }
            if (nt & 1) asm volatile("" ::: "memory");
        }
        const float wprev = expf(bt + mc - mt);
#pragma unroll
        for (int nt = 0; nt < 8; ++nt) { oacc[nt][0] *= wprev; oacc[nt][1] *= wprev; oacc[nt][2] *= wprev; oacc[nt][3] *= wprev; }
        __syncthreads();
#pragma unroll
        for (int ks = 0; ks < 2; ++ks) {
            const bf16x8 pf = *(const bf16x8*)&Ps[fr * LDT + ks * 32 + fq * 8];
#pragma unroll
            for (int nt = 0; nt < 8; ++nt) {
                const bf16x8 vt = tr_frag(Vs, LDW, ks * 32, nt * 16, lane);
                oacc[nt] = __builtin_amdgcn_mfma_f32_16x16x32_bf16(vt, pf, oacc[nt], 0, 0, 0);
            }
        }
        const float den = wprev * qn + rowsum;
        const float inv = 1.f / fmaxf(fabsf(den), expf(-mt));
        float s1 = 0.f;
#pragma unroll
        for (int nt = 0; nt < 8; ++nt)
#pragma unroll
            for (int j = 0; j < 4; ++j) { oacc[nt][j] *= inv; s1 += oacc[nt][j]; }
        const float mean = sumq(s1) * (1.f / 128.f);
        float s2 = 0.f;
#pragma unroll
        for (int nt = 0; nt < 8; ++nt)
#pragma unroll
            for (int j = 0; j < 4; ++j) { oacc[nt][j] -= mean; s2 += oacc[nt][j] * oacc[nt][j]; }
        const float rstd = rsqrtf(sumq(s2) * (1.f / 128.f) + LN_EPS);
        bf16_t* ym = (bf16_t*)(ws + WS_BUFA) + (size_t)(tok0 + trow) * D + 512 + h * 128;
        const bf16_t* orow = P + (size_t)(tok0 + trow) * NP + 2048 + h * 128;
#pragma unroll
        for (int nt = 0; nt < 8; ++nt) {
            const int e = nt * 16 + fq * 4;
            const float4 gg = *(const float4*)(p.mh_norm_g + h * 128 + e);
            const uint2 oo = *(const uint2*)(orow + e);
            const float y0 = oacc[nt][0] * rstd * gg.x * sigmoidf_(bf_lo(oo.x)), y1 = oacc[nt][1] * rstd * gg.y * sigmoidf_(bf_hi(oo.x));
            const float y2 = oacc[nt][2] * rstd * gg.z * sigmoidf_(bf_lo(oo.y)), y3 = oacc[nt][3] * rstd * gg.w * sigmoidf_(bf_hi(oo.y));
            *(uint2*)(ym + e) = uint2{pack2(y0, y1), pack2(y2, y3)};
        }
        __syncthreads();
    }
}

struct EpiOutPart {
    const float* xs; const float* mod; float* out; float* part; int ks;
    DEVI void operator()(const f32x4 (&acc)[2][2][4][2], const pg8::Unit& u, int wr, int wc, int fr, int fq) const {
#pragma unroll
        for (int ai = 0; ai < 2; ++ai)
#pragma unroll
            for (int m = 0; m < 4; ++m) {
                const int row = PG8_ROW(u, ai, m), rs = row - NTP;
                const float* x = xs + (size_t)rs * D;
                const float* g1 = mod + (size_t)seq_of(row) * NMOD + 2048;
                float* dst = ks == 0 ? out + (size_t)row * D : part + ((size_t)(ks - 1) * NTS + rs) * D;
                f32x4 xv[2][2], gv[2][2];
#pragma unroll
                for (int bj = 0; bj < 2; ++bj)
#pragma unroll
                    for (int n = 0; n < 2; ++n) { const int col = PG8_COL(u, bj, n); gv[bj][n] = *(const f32x4*)(g1 + col); xv[bj][n] = ks == 0 ? *(const f32x4*)(x + col) * ALPHA : f32x4{0.f, 0.f, 0.f, 0.f}; }
#pragma unroll
                for (int bj = 0; bj < 2; ++bj)
#pragma unroll
                    for (int n = 0; n < 2; ++n) *(f32x4*)(dst + PG8_COL(u, bj, n)) = xv[bj][n] + (gv[bj][n] + 1.f) * acc[ai][bj][m][n];
            }
    }
};

DEVI void phase6(const Params& p, unsigned char* smem) {
    unsigned char* ws = p.ws;
    {
        pg8::Gemm g{(const bf16_t*)(ws + WS_BUFA), (const bf16_t*)(ws + WS_WTOUT), NTP, D, D, D};
        pg8::StaticOrder S; S.init(NTP, D, (int)gridDim.x, (int)blockIdx.x);
        EpiOut E{p.x_prompt, p.x_sample, (const float*)(ws + WS_MOD), p.out};
        pg8::gemm_phase((LAS unsigned char*)smem, g, S, E);
    }
    {
        const int q = (int)blockIdx.x - ((int)gridDim.x - 32);
        const int qq = q < 0 ? 0 : q, ks = qq & 3;
        pg8::Gemm g{(const bf16_t*)(ws + WS_BUFA) + ks * 256, (const bf16_t*)(ws + WS_WTOUT) + ks * 256, NT, D, 256, D};
        pg8::OneUnit S{q >= 0, pg8::Unit{64 + (qq >> 4), (qq >> 2) & 3}};
        EpiOutPart E{p.x_sample, (const float*)(ws + WS_MOD), p.out, (float*)(ws + WS_PART), ks};
        pg8::gemm_phase((LAS unsigned char*)smem, g, S, E);
    }
}

DEVI void phase7(const Params& p) {
    unsigned char* ws = p.ws;
    const int tid = threadIdx.x, lane = tid & 63, w = tid >> 6;
    const float* mod = (const float*)(ws + WS_MOD);
    bf16_t* u2 = (bf16_t*)(ws + WS_BUFB);
    const int nw = gridDim.x * 8;
    for (int tok0 = blockIdx.x * 8 + w; tok0 < NT; tok0 += 2 * nw) {
        float v[2][16];
        const bool has2 = tok0 + nw < NT;
#pragma unroll
        for (int t = 0; t < 2; ++t) {
            const int tok = (t == 0 || has2) ? tok0 + t * nw : tok0;
            const float* x = p.out + (size_t)tok * D;
#pragma unroll
            for (int i = 0; i < 4; ++i) { const float4 q4 = *(const float4*)(x + i * 256 + lane * 4); v[t][i * 4] = q4.x; v[t][i * 4 + 1] = q4.y; v[t][i * 4 + 2] = q4.z; v[t][i * 4 + 3] = q4.w; }
            if (tok >= NTP) {
                const float* pp = (const float*)(ws + WS_PART) + (size_t)(tok - NTP) * D;
#pragma unroll
                for (int k = 0; k < 3; ++k)
#pragma unroll
                    for (int i = 0; i < 4; ++i) { const float4 q4 = *(const float4*)(pp + (size_t)k * NTS * D + i * 256 + lane * 4); v[t][i * 4] += q4.x; v[t][i * 4 + 1] += q4.y; v[t][i * 4 + 2] += q4.z; v[t][i * 4 + 3] += q4.w; }
            }
        }
#pragma unroll
        for (int t = 0; t < 2; ++t) {
            if (t == 1 && !has2) break;
            const int tok = tok0 + t * nw;
            float* x = p.out + (size_t)tok * D;
            const float* ms = mod + (size_t)seq_of(tok) * NMOD;
            float s = 0.f;
#pragma unroll
            for (int i = 0; i < 16; ++i) s += v[t][i];
            float mean = wave_sum(s) * (1.f / 1024.f);
            float q = 0.f;
#pragma unroll
            for (int i = 0; i < 16; ++i) { v[t][i] -= mean; q += v[t][i] * v[t][i]; }
            float rstd = rsqrtf(wave_sum(q) * (1.f / 1024.f) + LN_EPS);
            s = 0.f;
#pragma unroll
            for (int i = 0; i < 4; ++i) {
                const int c = i * 256 + lane * 4;
                const float4 g = *(const float4*)(p.ln1_g + c), bq = *(const float4*)(p.ln1_b + c);
                v[t][i * 4] = v[t][i * 4] * rstd * g.x + bq.x; v[t][i * 4 + 1] = v[t][i * 4 + 1] * rstd * g.y + bq.y;
                v[t][i * 4 + 2] = v[t][i * 4 + 2] * rstd * g.z + bq.z; v[t][i * 4 + 3] = v[t][i * 4 + 3] * rstd * g.w + bq.w;
                *(float4*)(x + c) = float4{v[t][i * 4], v[t][i * 4 + 1], v[t][i * 4 + 2], v[t][i * 4 + 3]};
                s += v[t][i * 4] + v[t][i * 4 + 1] + v[t][i * 4 + 2] + v[t][i * 4 + 3];
            }
            mean = wave_sum(s) * (1.f / 1024.f);
            q = 0.f;
#pragma unroll
            for (int i = 0; i < 16; ++i) { v[t][i] -= mean; q += v[t][i] * v[t][i]; }
            rstd = rsqrtf(wave_sum(q) * (1.f / 1024.f) + LN_EPS);
#pragma unroll
            for (int i = 0; i < 4; ++i) {
                const int c = i * 256 + lane * 4;
                const float4 sh = *(const float4*)(ms + 3072 + c), sc = *(const float4*)(ms + 4096 + c);
                *(uint2*)(u2 + (size_t)tok * D + c) = uint2{pack2(v[t][i * 4] * rstd * (1.f + sc.x) + sh.x, v[t][i * 4 + 1] * rstd * (1.f + sc.y) + sh.y),
                                                            pack2(v[t][i * 4 + 2] * rstd * (1.f + sc.z) + sh.z, v[t][i * 4 + 3] * rstd * (1.f + sc.w) + sh.w)};
            }
        }
    }
}

DEVI void combine_pair(const int* k0, const int* k1, int* ed, float* gd) {
        int ka[16], kb[16];
#pragma unroll
        for (int i = 0; i < 4; ++i) {
            const int4 a = *(const int4*)(k0 + i * 4), b = *(const int4*)(k1 + i * 4);
            ka[i * 4] = a.x; ka[i * 4 + 1] = a.y; ka[i * 4 + 2] = a.z; ka[i * 4 + 3] = a.w;
            kb[i * 4] = b.x; kb[i * 4 + 1] = b.y; kb[i * 4 + 2] = b.z; kb[i * 4 + 3] = b.w;
        }
        float va[16], vb[16];
#pragma unroll
        for (int i = 0; i < 16; ++i) { va[i] = key_val(ka[i], 0x7F); vb[i] = key_val(kb[i], 0x7F); }
        int R[16];
#define CAND(i, j) key_enc(va[i] + vb[j], ((i) << 4) | (j), 0xFF)
        {
            int N0[16] = {CAND(0,0), CAND(0,1), CAND(0,2), CAND(0,3), CAND(0,4), CAND(0,5), CAND(0,6), CAND(0,7), CAND(0,8), CAND(0,9), CAND(0,10), CAND(0,11), CAND(0,12), CAND(0,13), CAND(0,14), CAND(0,15)};
            bitonic_sort_desc<16>(N0);
#pragma unroll
            for (int i = 0; i < 16; ++i) R[i] = N0[i];
        }
        {
            int N1[16] = {CAND(1,0), CAND(1,1), CAND(1,2), CAND(1,3), CAND(1,4), CAND(1,5), CAND(1,6), CAND(1,7), CAND(2,0), CAND(2,1), CAND(2,2), CAND(2,3), CAND(2,4), CAND(3,0), CAND(3,1), CAND(3,2)};
            bitonic_sort_desc<16>(N1);
#pragma unroll
            for (int i = 0; i < 16; ++i) R[i] = max(R[i], N1[15 - i]);
            bitonic_merge16_desc(R);
        }
        {
            int N2[16] = {CAND(3,3), CAND(4,0), CAND(4,1), CAND(4,2), CAND(5,0), CAND(5,1), CAND(6,0), CAND(6,1), CAND(7,0), CAND(7,1), CAND(8,0), CAND(9,0), CAND(10,0), CAND(11,0), CAND(12,0), CAND(13,0)};
            bitonic_sort_desc<16>(N2);
#pragma unroll
            for (int i = 0; i < 16; ++i) R[i] = max(R[i], N2[15 - i]);
            bitonic_merge16_desc(R);
        }
        {
            int N3[16];
            N3[0] = max(CAND(14,0), CAND(15,0)); N3[1] = min(CAND(14,0), CAND(15,0));
#pragma unroll
            for (int i = 2; i < 16; ++i) N3[i] = (int)0x80000000;
#pragma unroll
            for (int i = 0; i < 16; ++i) R[i] = max(R[i], N3[15 - i]);
            bitonic_merge16_desc(R);
        }
#undef CAND
        float val[16]; int ex[16];
#pragma unroll
        for (int k = 0; k < 16; ++k) {
            const int i = (R[k] >> 4) & 15, j = R[k] & 15;
            const int a = k0[i], b = k1[j];
            val[k] = key_val(a, 0x7F) + key_val(b, 0x7F);
            ex[k] = (a & 0x7F) * 128 + (b & 0x7F);
        }
        float mx = val[0];
#pragma unroll
        for (int k = 1; k < 16; ++k) mx = fmaxf(mx, val[k]);
        float sum = 0.f;
#pragma unroll
        for (int k = 0; k < 16; ++k) { val[k] = expf(val[k] - mx); sum += val[k]; }
        const float inv = 1.f / sum;
#pragma unroll
        for (int k = 0; k < 16; k += 4) {
            *(int4*)(ed + k) = int4{ex[k], ex[k + 1], ex[k + 2], ex[k + 3]};
            *(float4*)(gd + k) = float4{val[k] * inv, val[k + 1] * inv, val[k + 2] * inv, val[k + 3] * inv};
        }
}

DEVI void phase8a(const Params& p, unsigned char* smem) {
    unsigned char* ws = p.ws;
    pg8::Gemm g{(const bf16_t*)(ws + WS_BUFB), (const bf16_t*)(ws + WS_WTQ), NT, 2048, D, D};
    pg8::StaticOrder S; S.init(NT, 2048, (int)gridDim.x, (int)blockIdx.x);
    EpiQ E{(bf16_t*)(ws + WS_Q)};
    pg8::gemm_phase((LAS unsigned char*)smem, g, S, E);
}

DEVI void phase8(const Params& p, unsigned char* smem_all) {
    unsigned char* smem = smem_all + VHALF * SMEM_HALF;
    unsigned char* ws = p.ws;
    const int tid = TID, lane = tid & 63, w = tid >> 6, wr = w >> 1, wc = w & 1, fr = lane & 15, fq = lane >> 4;
    const bf16_t* Q = (const bf16_t*)(ws + WS_Q);
    for (int it0 = blockIdx.x * 2; it0 < 132 * 16; it0 += NVB) {
        const int item = it0 + VHALF;
        const int mt = item >> 4, hp = item & 15;
        f32x4 acc[4][4];
        bf16_t* Qs = (bf16_t*)smem;
        bf16_t* Kb = (bf16_t*)(smem + 128 * LDW * 2);
#pragma unroll
        for (int i = 0; i < 8; ++i) {
            const int ch = tid + i * 256, r = ch >> 4, kc = ch & 15;
            *(uint4*)&Qs[r * LDW + kc * 8] = *(const uint4*)(Q + (size_t)(mt * 128 + r) * 2048 + hp * 128 + kc * 8);
            *(uint4*)&Kb[r * LDW + kc * 8] = *(const uint4*)((const bf16_t*)(ws + WS_KEYS) + hp * 16384 + r * 128 + kc * 8);
        }
        __syncthreads();
        mma_lds128(Qs, Kb, acc);
        __syncthreads();
        float* Sc = (float*)smem;
#pragma unroll
        for (int m = 0; m < 4; ++m)
#pragma unroll
            for (int n = 0; n < 4; ++n) {
                float* d = &Sc[(wr * 64 + m * 16 + fr) * 130 + wc * 64 + n * 16 + fq * 4];
                d[0] = acc[m][n][0]; d[1] = acc[m][n][1]; d[2] = acc[m][n][2]; d[3] = acc[m][n][3];
            }
        __syncthreads();
        {
            const int row = tid >> 1, half = tid & 1;
            const float* sr = &Sc[row * 130 + half];
            int R[16];
#pragma unroll
            for (int g = 0; g < 4; ++g) {
                int Nn[16];
#pragma unroll
                for (int i = 0; i < 16; ++i) { const int idx = 2 * (g * 16 + i) + half; Nn[i] = key_enc(sr[2 * (g * 16 + i)], idx, 0x7F); }
                bitonic_sort_desc<16>(Nn);
                if (g == 0) {
#pragma unroll
                    for (int i = 0; i < 16; ++i) R[i] = Nn[i];
                } else {
#pragma unroll
                    for (int i = 0; i < 16; ++i) R[i] = max(R[i], Nn[15 - i]);
                    bitonic_merge16_desc(R);
                }
            }
            int T[16];
#pragma unroll
            for (int i = 0; i < 16; ++i) T[i] = __shfl_xor(R[15 - i], 1);
#pragma unroll
            for (int i = 0; i < 16; ++i) R[i] = max(R[i], T[i]);
            bitonic_merge16_desc(R);
            __syncthreads();
            if (half == 0) {
                int* dst = (int*)smem + row * 16;
                *(int4*)dst = int4{R[0], R[1], R[2], R[3]}; *(int4*)(dst + 4) = int4{R[4], R[5], R[6], R[7]};
                *(int4*)(dst + 8) = int4{R[8], R[9], R[10], R[11]}; *(int4*)(dst + 12) = int4{R[12], R[13], R[14], R[15]};
            }
        }
        __syncthreads();
        if (threadIdx.x < 128) {
            const int tok = mt * 128 + (int)threadIdx.x, hh = hp >> 1;
            combine_pair((const int*)smem_all + threadIdx.x * 16, (const int*)(smem_all + SMEM_HALF) + threadIdx.x * 16,
                         (int*)(ws + WS_EG) + (size_t)tok * 128 + hh * 16, (float*)(ws + WS_GG) + (size_t)tok * 128 + hh * 16);
        }
        __syncthreads();
    }
}

DEVI float dpp_sum_to_lane63(float v) {
    v += __builtin_bit_cast(float, __builtin_amdgcn_update_dpp(0, __builtin_bit_cast(int, v), 0x111, 0xf, 0xf, true));
    v += __builtin_bit_cast(float, __builtin_amdgcn_update_dpp(0, __builtin_bit_cast(int, v), 0x112, 0xf, 0xf, true));
    v += __builtin_bit_cast(float, __builtin_amdgcn_update_dpp(0, __builtin_bit_cast(int, v), 0x114, 0xf, 0xf, true));
    v += __builtin_bit_cast(float, __builtin_amdgcn_update_dpp(0, __builtin_bit_cast(int, v), 0x118, 0xf, 0xf, true));
    v += __builtin_bit_cast(float, __builtin_amdgcn_update_dpp(0, __builtin_bit_cast(int, v), 0x142, 0xa, 0xf, false));
    v += __builtin_bit_cast(float, __builtin_amdgcn_update_dpp(0, __builtin_bit_cast(int, v), 0x143, 0xc, 0xf, false));
    return v;
}
DEVI float rdlane(float v, int l) { return __builtin_bit_cast(float, __builtin_amdgcn_readlane(__builtin_bit_cast(int, v), l)); }
DEVI int rdlanei(int v, int l) { return __builtin_amdgcn_readlane(v, l); }

DEVI void phase10(const Params& p, unsigned char* smem) {
    (void)smem;
    unsigned char* ws = p.ws;
    const int tid = threadIdx.x, lane = tid & 63, w = tid >> 6;
    const unsigned char* UT = ws + WS_UT;
    const unsigned char* VT = ws + WS_VT;
    const float* USC = (const float*)(ws + WS_USC);
    const float* VSC = (const float*)(ws + WS_VSC);
    const bf16_t* u2 = (const bf16_t*)(ws + WS_BUFB);
    const float* mod = (const float*)(ws + WS_MOD);
    unsigned* cnt = (unsigned*)(ws + WS_CTL) + CW_CNT;
    for (;;) {
        int tok = 0;
        if (lane == 0) tok = (int)atomicAdd(cnt, 1u);
        tok = __builtin_amdgcn_readfirstlane(tok);
        if (tok >= NT) break;
        const int* Eg = (const int*)(ws + WS_EG) + (size_t)tok * 128;
        const float* Gg = (const float*)(ws + WS_GG) + (size_t)tok * 128;
        const int ea = Eg[lane], eb = Eg[lane + 64];
        const float ga = Gg[lane], gb = Gg[lane + 64];
        const float sua = USC[ea], sub = USC[eb], sva = VSC[ea], svb = VSC[eb];
        f32x2 uf[8];
        {
            const uint4 q0 = *(const uint4*)(u2 + (size_t)tok * D + lane * 16), q1 = *(const uint4*)(u2 + (size_t)tok * D + lane * 16 + 8);
            uf[0] = f32x2{bf_lo(q0.x), bf_hi(q0.x)}; uf[1] = f32x2{bf_lo(q0.y), bf_hi(q0.y)}; uf[2] = f32x2{bf_lo(q0.z), bf_hi(q0.z)}; uf[3] = f32x2{bf_lo(q0.w), bf_hi(q0.w)};
            uf[4] = f32x2{bf_lo(q1.x), bf_hi(q1.x)}; uf[5] = f32x2{bf_lo(q1.y), bf_hi(q1.y)}; uf[6] = f32x2{bf_lo(q1.z), bf_hi(q1.z)}; uf[7] = f32x2{bf_lo(q1.w), bf_hi(q1.w)};
        }
        float act_a = 0.f, act_b = 0.f;
#pragma unroll
        for (int hb = 0; hb < 2; ++hb) {
            const int esel = hb ? eb : ea;
            float actv = 0.f;
            for (int jb = 0; jb < 64; jb += 16) {
#if UFP4
                uint2 x[16];
#pragma unroll
                for (int i = 0; i < 16; ++i) {
                    const int e = rdlanei(esel, jb + i);
                    x[i] = *(const uint2*)(UT + (size_t)e * 512 + lane * 8);
                }
#pragma unroll
                for (int i = 0; i < 16; ++i) {
                    f32x2 a2 = __builtin_amdgcn_cvt_scalef32_pk_f32_fp4(x[i].x, 1.0f, 0) * uf[0];
                    a2 += __builtin_amdgcn_cvt_scalef32_pk_f32_fp4(x[i].x, 1.0f, 1) * uf[1];
                    a2 += __builtin_amdgcn_cvt_scalef32_pk_f32_fp4(x[i].x, 1.0f, 2) * uf[2];
                    a2 += __builtin_amdgcn_cvt_scalef32_pk_f32_fp4(x[i].x, 1.0f, 3) * uf[3];
                    a2 += __builtin_amdgcn_cvt_scalef32_pk_f32_fp4(x[i].y, 1.0f, 0) * uf[4];
                    a2 += __builtin_amdgcn_cvt_scalef32_pk_f32_fp4(x[i].y, 1.0f, 1) * uf[5];
                    a2 += __builtin_amdgcn_cvt_scalef32_pk_f32_fp4(x[i].y, 1.0f, 2) * uf[6];
                    a2 += __builtin_amdgcn_cvt_scalef32_pk_f32_fp4(x[i].y, 1.0f, 3) * uf[7];
#else
                int4 x[16];
#pragma unroll
                for (int i = 0; i < 16; ++i) {
                    const int e = rdlanei(esel, jb + i);
                    x[i] = *(const int4*)(UT + (size_t)e * D + lane * 16);
                }
#pragma unroll
                for (int i = 0; i < 16; ++i) {
                    f32x2 a2 = __builtin_amdgcn_cvt_pk_f32_fp8(x[i].x, false) * uf[0];
                    a2 += __builtin_amdgcn_cvt_pk_f32_fp8(x[i].x, true) * uf[1];
                    a2 += __builtin_amdgcn_cvt_pk_f32_fp8(x[i].y, false) * uf[2];
                    a2 += __builtin_amdgcn_cvt_pk_f32_fp8(x[i].y, true) * uf[3];
                    a2 += __builtin_amdgcn_cvt_pk_f32_fp8(x[i].z, false) * uf[4];
                    a2 += __builtin_amdgcn_cvt_pk_f32_fp8(x[i].z, true) * uf[5];
                    a2 += __builtin_amdgcn_cvt_pk_f32_fp8(x[i].w, false) * uf[6];
                    a2 += __builtin_amdgcn_cvt_pk_f32_fp8(x[i].w, true) * uf[7];
#endif
                    const float tot = rdlane(dpp_sum_to_lane63(a2.x + a2.y), 63);
                    actv = (lane == jb + i) ? tot : actv;
                }
            }
            if (hb) act_b = actv; else act_a = actv;
        }
        const float cfa = ga * gelu_exact(act_a * sua) * sva;
        const float cfb = gb * gelu_exact(act_b * sub) * svb;
        f32x2 ya[8];
#pragma unroll
        for (int i = 0; i < 8; ++i) ya[i] = f32x2{0.f, 0.f};
#pragma unroll
        for (int hb = 0; hb < 2; ++hb) {
            const int esel = hb ? eb : ea;
            const float csel = hb ? cfb : cfa;
            for (int jb = 0; jb < 64; jb += 16) {
                uint2 x[16];
#pragma unroll
                for (int i = 0; i < 16; ++i) {
                    const int e = rdlanei(esel, jb + i);
                    x[i] = *(const uint2*)(VT + (size_t)e * 512 + lane * 8);
                }
#pragma unroll
                for (int i = 0; i < 16; ++i) {
                    const float cf = rdlane(csel, jb + i);
                    const f32x2 c2 = f32x2{cf, cf};
                    ya[0] += c2 * __builtin_amdgcn_cvt_scalef32_pk_f32_fp4(x[i].x, 1.0f, 0);
                    ya[1] += c2 * __builtin_amdgcn_cvt_scalef32_pk_f32_fp4(x[i].x, 1.0f, 1);
                    ya[2] += c2 * __builtin_amdgcn_cvt_scalef32_pk_f32_fp4(x[i].x, 1.0f, 2);
                    ya[3] += c2 * __builtin_amdgcn_cvt_scalef32_pk_f32_fp4(x[i].x, 1.0f, 3);
                    ya[4] += c2 * __builtin_amdgcn_cvt_scalef32_pk_f32_fp4(x[i].y, 1.0f, 0);
                    ya[5] += c2 * __builtin_amdgcn_cvt_scalef32_pk_f32_fp4(x[i].y, 1.0f, 1);
                    ya[6] += c2 * __builtin_amdgcn_cvt_scalef32_pk_f32_fp4(x[i].y, 1.0f, 2);
                    ya[7] += c2 * __builtin_amdgcn_cvt_scalef32_pk_f32_fp4(x[i].y, 1.0f, 3);
                }
            }
        }
        float* xo = p.out + (size_t)tok * D + lane * 16;
        const float* g2 = mod + (size_t)seq_of(tok) * NMOD + 5120 + lane * 16;
        float r[16];
        float s1 = 0.f;
#pragma unroll
        for (int i = 0; i < 4; ++i) {
            const float4 xv = *(const float4*)(xo + i * 4), gv = *(const float4*)(g2 + i * 4);
            r[i * 4 + 0] = ALPHA * xv.x + (1.f + gv.x) * ya[i * 2].x; r[i * 4 + 1] = ALPHA * xv.y + (1.f + gv.y) * ya[i * 2].y;
            r[i * 4 + 2] = ALPHA * xv.z + (1.f + gv.z) * ya[i * 2 + 1].x; r[i * 4 + 3] = ALPHA * xv.w + (1.f + gv.w) * ya[i * 2 + 1].y;
            s1 += r[i * 4] + r[i * 4 + 1] + r[i * 4 + 2] + r[i * 4 + 3];
        }
        const float mean = wave_sum(s1) * (1.f / 1024.f);
        float s2 = 0.f;
#pragma unroll
        for (int i = 0; i < 16; ++i) { r[i] -= mean; s2 += r[i] * r[i]; }
        const float rstd = rsqrtf(wave_sum(s2) * (1.f / 1024.f) + LN_EPS);
#pragma unroll
        for (int i = 0; i < 4; ++i) {
            const float4 la = *(const float4*)(p.ln2_g + lane * 16 + i * 4), ba = *(const float4*)(p.ln2_b + lane * 16 + i * 4);
            *(float4*)(xo + i * 4) = float4{r[i * 4] * rstd * la.x + ba.x, r[i * 4 + 1] * rstd * la.y + ba.y, r[i * 4 + 2] * rstd * la.z + ba.z, r[i * 4 + 3] * rstd * la.w + ba.w};
        }
    }
}

__global__ void __launch_bounds__(512, 2) mk_fwd(Params p, int ph_lo, int ph_hi, int use_cg) {
    extern __shared__ __attribute__((aligned(16))) unsigned char smem[];
    volatile LAS unsigned* xbw = (volatile LAS unsigned*)((LAS unsigned char*)smem + SMEM_BYTES);
    XcdBarrier bar; bar.bar = (unsigned*)(p.ws + WS_CTL) + CW_BAR; bar.x = 0; bar.st = xbw;
    if (ph_hi - ph_lo > 1 && !use_cg) {
        if (threadIdx.x < 4) xbw[threadIdx.x] = 0u;
        __syncthreads();
        bar = xcd_barrier_post((unsigned*)(p.ws + WS_CTL) + CW_BAR, xbw);
    }
#define SEAM(k) do { if (ph_lo <= (k) && (k) + 1 < ph_hi) { if (use_cg) cg::this_grid().sync(); else xcd_barrier(bar); } } while (0)
#define RUN(k) (ph_lo <= (k) && (k) < ph_hi)
    if (RUN(0)) phase0(p, smem);
    SEAM(0);
    if (RUN(1)) phase1(p, smem);
    SEAM(1);
    if (RUN(2)) phase2(p, smem);
    SEAM(2);
#ifndef REPA
#define REPA 1
#endif
#ifndef REPB
#define REPB 1
#endif
#ifndef REPC
#define REPC 1
#endif
#ifndef REPD
#define REPD 1
#endif
    if (RUN(3)) for (int r = 0; r < REPA; ++r) { phase3(p, smem); if (r + 1 < REPA) xcd_barrier(bar); }
    SEAM(3);
    if (RUN(4)) for (int r = 0; r < REPB; ++r) { phase4(p, smem); if (r + 1 < REPB) xcd_barrier(bar); }
    SEAM(4);
    if (RUN(5)) phase5(p, smem);
    SEAM(5);
    if (RUN(6)) phase6(p, smem);
    SEAM(6);
    if (RUN(7)) phase7(p);
    SEAM(7);
    if (RUN(8)) for (int r = 0; r < REPC; ++r) { phase8a(p, smem); if (r + 1 < REPC) xcd_barrier(bar); }
    SEAM(8);
    if (RUN(9)) for (int r = 0; r < REPD; ++r) { phase8(p, smem); if (r + 1 < REPD) xcd_barrier(bar); }
    SEAM(9);
    if (RUN(10)) phase10(p, smem);
}

extern "C" void kernel_launch(void* const* d_in, const int* in_sizes, int n_in, void* d_out, int out_size, void* d_ws, size_t ws_size, hipStream_t stream) {
    static int grid = 0;
    if (grid == 0) {
        int dev = 0, cus = 0, per_cu = 0;
        (void)hipGetDevice(&dev);
        (void)hipDeviceGetAttribute(&cus, hipDeviceAttributeMultiprocessorCount, dev);
        (void)hipFuncSetAttribute((const void*)mk_fwd, hipFuncAttributeMaxDynamicSharedMemorySize, LDS_DYN);
        (void)hipOccupancyMaxActiveBlocksPerMultiprocessor(&per_cu, (const void*)mk_fwd, 512, LDS_DYN);
        if (per_cu < 1) fprintf(stderr, "kernel_launch: occupancy query says %d workgroups per CU\n", per_cu);
        grid = cus;
        if (ws_size < WS_END) fprintf(stderr, "kernel_launch: workspace too small: %zu < %zu\n", ws_size, (size_t)WS_END);
    }
    Params p{};
    const float** f = (const float**)&p;
    for (int i = 0; i < 24; ++i) f[i] = (const float*)d_in[i];
    p.out = (float*)d_out; p.ws = (unsigned char*)d_ws;
    (void)hipMemsetAsync((unsigned char*)d_ws + WS_CTL, 0, 65536, stream);
    int lo = 0, hi = NPH, ucg = 0;
    void* args[] = {&p, &lo, &hi, &ucg};
    hipError_t e = hipLaunchCooperativeKernel((const void*)mk_fwd, dim3(grid), dim3(512), args, LDS_DYN, stream);
    if (e != hipSuccess) fprintf(stderr, "cooperative launch failed: %s (grid %d)\n", hipGetErrorString(e), grid);
}
#ifdef TEST4
__global__ void __launch_bounds__(512, 2) t4(Params p) { extern __shared__ __attribute__((aligned(16))) unsigned char sm4[]; phase4(p, sm4); }
__global__ void __launch_bounds__(512, 2) t4s(Params p) { extern __shared__ __attribute__((aligned(16))) unsigned char sm4[]; p4_state_scan(p, sm4 + VHALF * SMEM_HALF, blockIdx.x * 2 + VHALF); }
__global__ void __launch_bounds__(512, 2) t3(Params p) { extern __shared__ __attribute__((aligned(16))) unsigned char sm4[]; phase3(p, sm4); }
__global__ void __launch_bounds__(512, 2) t6(Params p) { extern __shared__ __attribute__((aligned(16))) unsigned char sm4[]; phase6(p, sm4); }
#endif
```

```cpp
#include <hip/hip_runtime.h>
#include <hip/hip_cooperative_groups.h>
#include <cstdio>
#include <cstdint>
namespace cg = cooperative_groups;


#ifndef UFP4
#define UFP4 1
#endif
#ifndef FUSED
#define FUSED 1
#endif

#define DEVI __device__ __forceinline__
#define TID ((int)(threadIdx.x & 255u))
#define VHALF ((int)(threadIdx.x >> 8))
#define NVB ((int)gridDim.x * 2)
#define LAS __attribute__((address_space(3)))

typedef unsigned short bf16_t;
typedef short bf16x8 __attribute__((ext_vector_type(8)));
typedef short s16x4 __attribute__((ext_vector_type(4)));
typedef float f32x4 __attribute__((ext_vector_type(4)));
typedef unsigned u32x4 __attribute__((ext_vector_type(4)));
typedef __bf16 bf2_t __attribute__((ext_vector_type(2)));

constexpr int D = 1024, NTP = 16384, NTS = 512, NT = NTP + NTS, SEQ = 2048, NSEQ = 136;
constexpr int DIN = 2568, NP = 2560, NMOD = 6144;
constexpr int NPH = 11;
constexpr float ALPHA = 1.189207115002721f;
constexpr float LN_EPS = 1e-5f;
constexpr float KSCALE = 0.08838834764831845f;

constexpr size_t O_Y = 0, O_POOLP = 17301504, O_CP = 17362944, O_NP = 17887232, O_MP = 17891328,
                 O_POOLS = 17891360, O_CS = 18874400, O_NS = 27263008, O_MS = 27328544;

constexpr size_t WS_CTL = 0;
constexpr size_t WS_MOD = 65536;
constexpr size_t WS_GATES = WS_MOD + 6291456;
constexpr size_t WS_MST = WS_GATES + 540672;
constexpr size_t WS_NST = WS_MST + 8192;
constexpr size_t WS_WTIN = WS_NST + 524288;
constexpr size_t WS_WTOUT = WS_WTIN + 5242880;
constexpr size_t WS_WTQ = WS_WTOUT + 2097152;
constexpr size_t WS_WTMOD = WS_WTQ + 4194304;
constexpr size_t WS_GA = WS_WTMOD;
constexpr size_t WS_BB = WS_GA + 262144;
constexpr size_t WS_RR = WS_BB + 262144;
constexpr size_t WS_RPM = WS_RR + 262144;
constexpr size_t WS_BCH = WS_RPM + 262144;
constexpr size_t WS_WTPOOL = WS_WTMOD + 12582912;
constexpr size_t WS_KEYS = WS_WTPOOL + 131072;
constexpr size_t WS_AMOD = WS_KEYS + 524288;
constexpr size_t WS_UT = WS_AMOD + 524288;
constexpr size_t WS_USC = WS_UT + 16777216;
constexpr size_t WS_VT = WS_UT + 33554432;
constexpr size_t WS_VSC = WS_VT + 16777216;
constexpr size_t WS_BUFA = WS_VT + 33554432;
constexpr size_t WS_BUFB = WS_BUFA + 34603008;
constexpr size_t WS_P = WS_BUFB + 34603008;
constexpr size_t WS_PART = WS_P;
constexpr size_t WS_Q = WS_P;
constexpr size_t WS_K16 = WS_P + 69206016;
constexpr size_t WS_EG = WS_BUFA;
constexpr size_t WS_GG = WS_EG + 8650752;
constexpr size_t WS_END = WS_P + 86507520;

constexpr int CW_BAR = 0;
constexpr int CW_CNT = 4096;

struct Params {
    const float *x_prompt, *x_sample, *c_prompt, *c_sample, *state_pool, *state_C, *state_n, *state_m;
    const float *w_mod, *b_mod, *w_in, *b_in, *w_pool, *pool_scale, *mh_norm_g, *w_out, *ln1_g, *ln1_b;
    const float *w_q, *sub_keys, *u_tab, *v_tab, *ln2_g, *ln2_b;
    float* out;
    unsigned char* ws;
};

typedef float f32x2 __attribute__((ext_vector_type(2)));
DEVI unsigned pack2(float lo, float hi) { const f32x2 v = {lo, hi}; const bf2_t b = __builtin_convertvector(v, bf2_t); return __builtin_bit_cast(unsigned, b); }
DEVI float dot2bf(unsigned a, unsigned b, float c) { return __builtin_amdgcn_fdot2_f32_bf16(__builtin_bit_cast(bf2_t, a), __builtin_bit_cast(bf2_t, b), c, false); }
DEVI float bf_lo(unsigned u) { return __uint_as_float(u << 16); }
DEVI float bf_hi(unsigned u) { return __uint_as_float(u & 0xFFFF0000u); }
DEVI float bf1(bf16_t h) { return __uint_as_float(((unsigned)h) << 16); }
DEVI float wave_sum(float v) {
#pragma unroll
    for (int o = 32; o > 0; o >>= 1) v += __shfl_xor(v, o);
    return v;
}
DEVI float sum16(float v) {
#pragma unroll
    for (int o = 8; o > 0; o >>= 1) v += __shfl_xor(v, o);
    return v;
}
DEVI float sumq(float v) {
    v += __shfl_xor(v, 16); v += __shfl_xor(v, 32); return v;
}
DEVI float logsigmoid(float x) { return fminf(x, 0.f) - log1pf(expf(-fabsf(x))); }
DEVI float sigmoidf_(float x) { return 1.f / (1.f + expf(-x)); }
DEVI float gelu_exact(float x) { return 0.5f * x * (1.f + erff(x * 0.7071067811865476f)); }
DEVI float scan_sum_incl(float v, int lane) {
#pragma unroll
    for (int o = 1; o < 64; o <<= 1) { float t = __shfl_up(v, o); if (lane >= o) v += t; }
    return v;
}
DEVI float scan_max_incl(float v, int lane) {
#pragma unroll
    for (int o = 1; o < 64; o <<= 1) { float t = __shfl_up(v, o); if (lane >= o) v = fmaxf(v, t); }
    return v;
}
DEVI const float* xrow_ptr(const Params& p, int tok) { return tok < NTP ? p.x_prompt + (size_t)tok * D : p.x_sample + (size_t)(tok - NTP) * D; }
DEVI int seq_of(int tok) { return tok < NTP ? (tok >> 11) : 8 + ((tok - NTP) >> 2); }

DEVI int key_enc(float f, int payload, int mask) { int b = __float_as_int(f); int k = b ^ ((b >> 31) & 0x7FFFFFFF); return (k & ~mask) | payload; }
DEVI float key_val(int k, int mask) { int k2 = k & ~mask; return __int_as_float(k2 ^ ((k2 >> 31) & 0x7FFFFFFF)); }

template <int N> DEVI void bitonic_sort_desc(int (&a)[N]) {
#pragma unroll
    for (int k = 2; k <= N; k <<= 1) {
#pragma unroll
        for (int j = k >> 1; j > 0; j >>= 1) {
#pragma unroll
            for (int i = 0; i < N; ++i) {
                const int l = i ^ j;
                if (l > i) {
                    const bool desc = ((i & k) == 0);
                    const int mx = max(a[i], a[l]), mn = min(a[i], a[l]);
                    a[i] = desc ? mx : mn; a[l] = desc ? mn : mx;
                }
            }
        }
    }
}
DEVI void bitonic_merge16_desc(int (&a)[16]) {
#pragma unroll
    for (int j = 8; j > 0; j >>= 1) {
#pragma unroll
        for (int i = 0; i < 16; ++i) {
            const int l = i ^ j;
            if (l > i) { const int mx = max(a[i], a[l]), mn = min(a[i], a[l]); a[i] = mx; a[l] = mn; }
        }
    }
}

#define XB_TMO      128
#define XB_XCNT(j)  (256  + 64 * (j))
#define XB_XSUB(j)  (1280 + 64 * (j))
#define XB_XGEN(j)  (2304 + 64 * (j))
#define XB_TOP      3328
#define XB_TOPGEN   3392
#define XCD_BAR_WORDS 3456
#define XB_SPIN_CAP (1u << 22)
DEVI unsigned xb_ld(unsigned* p) { return __hip_atomic_load(p, __ATOMIC_RELAXED, __HIP_MEMORY_SCOPE_AGENT); }
DEVI unsigned xb_add(unsigned* p, unsigned v) { return __hip_atomic_fetch_add(p, v, __ATOMIC_RELAXED, __HIP_MEMORY_SCOPE_AGENT); }
DEVI unsigned xb_xcc_id() { return (unsigned)__builtin_amdgcn_s_getreg((3 << 11) | 20) & 0xFu; }
#define XB_SPIN(cond, bar) do { unsigned _sp = 0; while (cond) { __builtin_amdgcn_s_sleep(1); \
    if ((++_sp & 255u) == 0u) { if (xb_ld(&(bar)[XB_TMO])) break; if (_sp > XB_SPIN_CAP) { atomicAdd(&(bar)[XB_TMO], 1u); break; } } } } while (0)
struct XcdBarrier { unsigned* bar; unsigned x; volatile LAS unsigned* st; };
DEVI XcdBarrier xcd_barrier_post(unsigned* bar, volatile LAS unsigned* st) {
    XcdBarrier b; b.bar = bar; b.x = xb_xcc_id(); b.st = st;
    if (threadIdx.x == 0) (void)xb_add(&bar[XB_XCNT(b.x)], 1u);
    return b;
}
DEVI void xcd_barrier_complete(unsigned* bar, unsigned x, unsigned& nloc, unsigned& nx) {
    const unsigned G = gridDim.x * gridDim.y * gridDim.z;
    unsigned sum, cnt, mine, sp = 0u;
    for (;;) {
        sum = 0u; cnt = 0u; mine = 0u;
#pragma unroll
        for (unsigned j = 0; j < 16; ++j) { const unsigned c = xb_ld(&bar[XB_XCNT(j)]); sum += c; cnt += (c > 0u) ? 1u : 0u; mine = (j == x) ? c : mine; }
        if (sum == G) break;
        __builtin_amdgcn_s_sleep(1);
        if ((++sp & 255u) == 0u) { if (xb_ld(&bar[XB_TMO])) break; if (sp > XB_SPIN_CAP) { atomicAdd(&bar[XB_TMO], 1u); break; } }
    }
    nloc = mine > 0u ? mine : 1u; nx = cnt > 0u ? cnt : 1u;
}
DEVI void xcd_barrier(const XcdBarrier& b) {
    asm volatile("s_waitcnt vmcnt(0)" ::: "memory");
    __syncthreads();
    if (threadIdx.x == 0) {
        unsigned* bar = b.bar;
        __builtin_amdgcn_s_waitcnt(0);
        unsigned nloc = b.st[0], nx = b.st[1];
        if (nloc == 0u) { xcd_barrier_complete(bar, b.x, nloc, nx); b.st[0] = nloc; b.st[1] = nx; }
        const unsigned old = xb_add(&bar[XB_XSUB(b.x)], 1u);
        const unsigned gen = old / nloc;
        if (old + 1u == (gen + 1u) * nloc) {
            __builtin_amdgcn_fence(__ATOMIC_RELEASE, "agent");
            asm volatile("s_waitcnt vmcnt(0)" ::: "memory");
            const unsigned og = xb_add(&bar[XB_TOP], 1u);
            const unsigned tg = og / nx;
            if (og + 1u == (tg + 1u) * nx) xb_add(&bar[XB_TOPGEN], 1u);
            else XB_SPIN(xb_ld(&bar[XB_TOPGEN]) == tg, bar);
            __builtin_amdgcn_fence(__ATOMIC_ACQUIRE, "agent");
            xb_add(&bar[XB_XGEN(b.x)], 1u);
            asm volatile("s_waitcnt vmcnt(0)" ::: "memory");
        } else {
            XB_SPIN(xb_ld(&bar[XB_XGEN(b.x)]) == gen, bar);
            __builtin_amdgcn_fence(__ATOMIC_ACQUIRE, "agent");
            asm volatile("s_waitcnt vmcnt(0)" ::: "memory");
        }
    }
    __syncthreads();
}

constexpr int SMEM_HALF = 73728;
constexpr int SMEM_BYTES = 2 * SMEM_HALF;
constexpr int LDS_DYN = SMEM_BYTES + 64;
constexpr int LDT = 72;
constexpr int LDW = 136;

DEVI void mma_lds128(const bf16_t* Al, const bf16_t* Bl, f32x4 (&acc)[4][4]) {
    const int tid = TID, lane = tid & 63, w = tid >> 6, wr = w >> 1, wc = w & 1, fr = lane & 15, fq = lane >> 4;
#pragma unroll
    for (int m = 0; m < 4; ++m)
#pragma unroll
        for (int n = 0; n < 4; ++n) acc[m][n] = f32x4{0.f, 0.f, 0.f, 0.f};
#pragma unroll
    for (int ks = 0; ks < 4; ++ks) {
        bf16x8 a[4], b[4];
#pragma unroll
        for (int m = 0; m < 4; ++m) a[m] = *(const bf16x8*)&Al[(wr * 64 + m * 16 + fr) * LDW + ks * 32 + fq * 8];
#pragma unroll
        for (int n = 0; n < 4; ++n) b[n] = *(const bf16x8*)&Bl[(wc * 64 + n * 16 + fr) * LDW + ks * 32 + fq * 8];
#pragma unroll
        for (int m = 0; m < 4; ++m)
#pragma unroll
            for (int n = 0; n < 4; ++n) acc[m][n] = __builtin_amdgcn_mfma_f32_16x16x32_bf16(b[n], a[m], acc[m][n], 0, 0, 0);
    }
}

DEVI bf16x8 tr_frag(const bf16_t* base, int ld, int row0, int col0, int lane) {
    const int g = lane >> 4, li = lane & 15, q = li >> 2, pp = li & 3;
    const bf16_t* a0 = base + (row0 + g * 8 + q) * ld + col0 + pp * 4;
    s16x4 lo = __builtin_amdgcn_ds_read_tr16_b64_v4i16((LAS s16x4*)a0);
    s16x4 hi = __builtin_amdgcn_ds_read_tr16_b64_v4i16((LAS s16x4*)(a0 + 4 * ld));
    return bf16x8{lo[0], lo[1], lo[2], lo[3], hi[0], hi[1], hi[2], hi[3]};
}


namespace pg8 {
constexpr int BM = 256, BK = 64, HALF = 128, HTB = HALF * BK * 2, STAGE_BYTES = 8 * HTB, NXCD = 8, WGM = 8;
__host__ __device__ __forceinline__ int lds_byte(int r, int c) { const int st = (r >> 4) * 2 + (c >> 5), rr = r & 15, cc = c & 31, ob = rr * 64 + cc * 2; return st * 1024 + (ob ^ (((ob >> 9) & 1) << 5)); }
__host__ __device__ __forceinline__ void stage_rc(int b, int& R, int& C) { const int st = b / 1024, sb = b % 1024, swz = sb ^ (((sb >> 9) & 1) << 5); R = (st >> 1) * 16 + swz / 64; C = (st & 1) * 32 + (swz % 64) / 2; }
__host__ __device__ __forceinline__ int perm32(int rho) { const int n = rho >> 4, i = rho & 15; return 8 * (i >> 2) + 4 * n + (i & 3); }
struct Unit { int pm, pn; };
struct Gemm { const bf16_t* A; const bf16_t* Bt; int M, N, K, ld; };
struct StaticOrder {
    int nM, nN, nwg, G, c;
    __device__ void init(int M, int N, int G_, int c_) { nM = M / BM; nN = N / BM; nwg = nM * nN; G = G_; c = c_; }
    __device__ bool next(int i, Unit& u) const {
        const long L = (long)i * G + c; if (L >= nwg) return false;
        int wgid = (int)L; { const int q = nwg / NXCD, r = nwg % NXCD, xcd = wgid % NXCD, off = wgid / NXCD; wgid = (xcd < r ? xcd * (q + 1) : r * (q + 1) + (xcd - r) * q) + off; }
        const int nig = WGM * nN, gid = wgid / nig, fm = gid * WGM, gsz = (nM - fm) < WGM ? (nM - fm) : WGM;
        u.pm = fm + ((wgid % nig) % gsz); u.pn = (wgid % nig) / gsz; return true;
    }
};
struct OneUnit {
    bool has; Unit u;
    __device__ bool next(int i, Unit& o) const { if (i != 0 || !has) return false; o = u; return true; }
};
template <class Epi, class Order>
__device__ __forceinline__ void gemm_phase(LAS unsigned char* lds, const Gemm g, const Order& S, const Epi& E) {
    const int tid = threadIdx.x, wid = __builtin_amdgcn_readfirstlane(tid >> 6), lane = tid & 63, wr = wid >> 2, wc = wid & 3, fr = lane & 15, fq = lane >> 4;
    const int K = g.K, nt = K / BK, LD = g.ld;
    unsigned voffA[2], voffB[2];
#pragma unroll
    for (int i = 0; i < 2; ++i) { int R, C; stage_rc(tid * 16 + i * 8192, R, C); const int Rb = (R & ~31) + perm32(R & 31);
        voffA[i] = (unsigned)(R * LD + C) * 2u; voffB[i] = (unsigned)(Rb * LD + C) * 2u; }
    const size_t kstep = (size_t)(BK * 2);
    const size_t hstep = (size_t)HALF * LD * 2;
    const size_t tstep = 2 * hstep;
    const unsigned ldsw = (unsigned)wid * 1024u;
    const int aoff = lds_byte(wr * 64 + fr, fq * 8), boff = lds_byte(wc * 32 + fr, fq * 8);
#define PG8_SA(b, h) (((b) * 2 + (h)) * HTB)
#define PG8_SB(b, h) ((4 + (b) * 2 + (h)) * HTB)
#define PG8_STAGE(bufoff, gbase, voff) do { _Pragma("unroll") for (int _i = 0; _i < 2; ++_i) \
        __builtin_amdgcn_global_load_lds((const unsigned*)((const char*)(gbase) + (voff)[_i]), (LAS unsigned*)(lds + (bufoff) + ldsw + _i * 8192), 16, 0, 0); } while (0)
#define PG8_LDA(dst, b, h) do { _Pragma("unroll") for (int m = 0; m < 4; ++m) _Pragma("unroll") for (int k = 0; k < 2; ++k) dst[m][k] = *(const LAS bf16x8*)(lds + PG8_SA(b, h) + aoff + m * 2048 + k * 1024); } while (0)
#define PG8_LDB(dst, b, h) do { _Pragma("unroll") for (int n = 0; n < 2; ++n) _Pragma("unroll") for (int k = 0; k < 2; ++k) dst[n][k] = *(const LAS bf16x8*)(lds + PG8_SB(b, h) + boff + n * 2048 + k * 1024); } while (0)
#define PG8_MMA(ai, bj, At, Bt) do { __builtin_amdgcn_s_setprio(1); _Pragma("unroll") for (int m = 0; m < 4; ++m) _Pragma("unroll") for (int n = 0; n < 2; ++n) _Pragma("unroll") for (int k = 0; k < 2; ++k) \
        acc[ai][bj][m][n] = __builtin_amdgcn_mfma_f32_16x16x32_bf16(Bt[n][k], At[m][k], acc[ai][bj][m][n], 0, 0, 0); __builtin_amdgcn_s_setprio(0); } while (0)
#define PG8_WAIT_V(n) asm volatile("s_waitcnt vmcnt(" #n ")" ::: "memory")
#define PG8_WAIT_L(n) asm volatile("s_waitcnt lgkmcnt(" #n ")" ::: "memory")
#define PG8_BAR __builtin_amdgcn_s_barrier()
#define PG8_SCHED __builtin_amdgcn_sched_barrier(0)
    Unit cur, nxt; int ui = 0;
    if (!S.next(0, cur)) return;
    f32x4 acc[2][2][4][2];
#pragma unroll
    for (int a = 0; a < 2; ++a)
#pragma unroll
        for (int b = 0; b < 2; ++b)
#pragma unroll
            for (int m = 0; m < 4; ++m)
#pragma unroll
                for (int n = 0; n < 2; ++n) acc[a][b][m][n] = (f32x4){0.f, 0.f, 0.f, 0.f};
    bf16x8 At[4][2], B0[2][2], B1[2][2];
    const char* cA = (const char*)g.A + (size_t)cur.pm * tstep; const char* cB = (const char*)g.Bt + (size_t)cur.pn * tstep;
    PG8_STAGE(PG8_SB(0, 0), cB, voffB); PG8_STAGE(PG8_SB(0, 1), cB + hstep, voffB); PG8_STAGE(PG8_SA(0, 0), cA, voffA); PG8_STAGE(PG8_SA(0, 1), cA + hstep, voffA);
    if (wr == 1) PG8_BAR;
    PG8_WAIT_V(2); PG8_BAR;
    PG8_STAGE(PG8_SB(1, 0), cB + kstep, voffB); PG8_STAGE(PG8_SA(1, 0), cA + kstep, voffA); PG8_STAGE(PG8_SB(1, 1), cB + hstep + kstep, voffB);
    PG8_WAIT_V(6); PG8_BAR;
    for (;;) {
        const bool has_next = S.next(ui + 1, nxt);
        const char* nA = has_next ? (const char*)g.A + (size_t)nxt.pm * tstep : cA; const char* nB = has_next ? (const char*)g.Bt + (size_t)nxt.pn * tstep : cB;
        for (int t = 0; t < nt; t += 2) {
            const bool last = (t == nt - 2);
            const char* a1 = cA + (size_t)(t + 1) * kstep;
            const char* a2 = last ? nA : cA + (size_t)(t + 2) * kstep; const char* b2 = last ? nB : cB + (size_t)(t + 2) * kstep;
            const char* a3 = a2 + kstep; const char* b3 = b2 + kstep;
            PG8_LDB(B0, 0, 0); PG8_LDB(B1, 0, 1); PG8_SCHED; PG8_LDA(At, 0, 0); PG8_STAGE(PG8_SA(1, 1), a1 + hstep, voffA);
            PG8_WAIT_V(8); PG8_WAIT_L(0); PG8_BAR; PG8_MMA(0, 0, At, B0); PG8_MMA(0, 1, At, B1); PG8_BAR; PG8_SCHED;
            PG8_LDA(At, 0, 1); PG8_STAGE(PG8_SB(0, 0), b2, voffB); PG8_STAGE(PG8_SB(0, 1), b2 + hstep, voffB); PG8_STAGE(PG8_SA(0, 0), a2, voffA);
            PG8_WAIT_V(8); PG8_WAIT_L(0); PG8_BAR; PG8_MMA(1, 0, At, B0); PG8_MMA(1, 1, At, B1); PG8_BAR; PG8_SCHED;
            PG8_LDB(B0, 1, 0); PG8_LDB(B1, 1, 1); PG8_SCHED; PG8_LDA(At, 1, 0); PG8_STAGE(PG8_SA(0, 1), a2 + hstep, voffA);
            PG8_WAIT_V(8); PG8_WAIT_L(0); PG8_BAR; PG8_MMA(0, 0, At, B0); PG8_MMA(0, 1, At, B1); PG8_BAR; PG8_SCHED;
            PG8_LDA(At, 1, 1); PG8_STAGE(PG8_SB(1, 0), b3, voffB); PG8_STAGE(PG8_SB(1, 1), b3 + hstep, voffB); PG8_STAGE(PG8_SA(1, 0), a3, voffA);
            PG8_WAIT_V(8); PG8_WAIT_L(0); PG8_BAR; PG8_MMA(1, 0, At, B0); PG8_MMA(1, 1, At, B1); PG8_BAR; PG8_SCHED;
        }
        if (wr == 0) PG8_BAR;
        E(acc, cur, wr, wc, fr, fq);
        if (!has_next) break;
#pragma unroll
        for (int a = 0; a < 2; ++a)
#pragma unroll
            for (int b = 0; b < 2; ++b)
#pragma unroll
                for (int m = 0; m < 4; ++m)
#pragma unroll
                    for (int n = 0; n < 2; ++n) acc[a][b][m][n] = (f32x4){0.f, 0.f, 0.f, 0.f};
        cur = nxt; cA = nA; cB = nB; ++ui;
        if (wr == 1) PG8_BAR;
    }
    PG8_WAIT_V(0);
    PG8_BAR;
#undef PG8_SA
#undef PG8_SB
#undef PG8_STAGE
#undef PG8_LDA
#undef PG8_LDB
#undef PG8_MMA
#undef PG8_WAIT_V
#undef PG8_WAIT_L
#undef PG8_BAR
#undef PG8_SCHED
}
#define PG8_ROW(u, ai, m) ((u).pm * 256 + (ai) * 128 + wr * 64 + (m) * 16 + fr)
#define PG8_COL(u, bj, n) ((u).pn * 256 + (bj) * 128 + wc * 32 + fq * 8 + (n) * 4)
}

DEVI void transpose_tile(const float* __restrict__ src, int ld, bf16_t* __restrict__ dst, int K, int k0, int n0, float* tile) {
    const int tid = TID;
    const int n = tid & 63, kq = tid >> 6;
#pragma unroll 4
    for (int i = 0; i < 16; ++i) { const int k = kq * 16 + i; tile[k * 65 + n] = src[(size_t)(k0 + k) * ld + n0 + n]; }
    __syncthreads();
    const int kp = tid & 31, nq = tid >> 5;
#pragma unroll 4
    for (int i = 0; i < 8; ++i) {
        const int nn = nq * 8 + i;
        const float a = tile[(2 * kp) * 65 + nn], b = tile[(2 * kp + 1) * 65 + nn];
        *(unsigned*)&dst[(size_t)(n0 + nn) * K + k0 + 2 * kp] = pack2(a, b);
    }
    __syncthreads();
}

DEVI void phase0(const Params& p, unsigned char* smem) {
    float* tile = (float*)(smem + VHALF * SMEM_HALF);
    unsigned char* ws = p.ws;
    const int tid = TID;
    constexpr int T_IN = 640, T_OUT = 256, T_Q = 512, T_MOD = 1536, T_POOL = 16;
    constexpr int T_ALL = T_IN + T_OUT + T_Q + T_MOD + T_POOL;
    constexpr int L_KEYS = 128, L_AMOD = 128, L_POOL = 352;
    for (int it0 = blockIdx.x * 2; it0 < T_ALL; it0 += NVB) {
        int it = it0 + VHALF;
        if (it < T_IN) { transpose_tile(p.w_in, DIN, (bf16_t*)(ws + WS_WTIN), 1024, (it / 40) * 64, (it % 40) * 64, tile); continue; }
        it -= T_IN;
        if (it < T_OUT) { transpose_tile(p.w_out, 1024, (bf16_t*)(ws + WS_WTOUT), 1024, (it / 16) * 64, (it % 16) * 64, tile); continue; }
        it -= T_OUT;
        if (it < T_Q) { transpose_tile(p.w_q, 2048, (bf16_t*)(ws + WS_WTQ), 1024, (it / 32) * 64, (it % 32) * 64, tile); continue; }
        it -= T_Q;
        if (it < T_MOD) { transpose_tile(p.w_mod, NMOD, (bf16_t*)(ws + WS_WTMOD), 1024, (it / 96) * 64, (it % 96) * 64, tile); continue; }
        it -= T_MOD;
        { const int g = it >> 2, r = it & 3; transpose_tile(p.w_pool + g * 16384, 128, (bf16_t*)(ws + WS_WTPOOL) + g * 16384, 128, (r >> 1) * 64, (r & 1) * 64, tile); }
    }
    for (int item = blockIdx.x * 2 + VHALF; item < L_KEYS + L_AMOD + L_POOL; item += NVB) {
        int it = item;
        if (it < L_KEYS) {
            const size_t e = (size_t)it * 2048 + tid * 8;
            const float4 a = *(const float4*)(p.sub_keys + e), b = *(const float4*)(p.sub_keys + e + 4);
            *(uint4*)((bf16_t*)(ws + WS_KEYS) + e) = uint4{pack2(a.x, a.y), pack2(a.z, a.w), pack2(b.x, b.y), pack2(b.z, b.w)};
            continue;
        }
        it -= L_KEYS;
        if (it < L_AMOD) {
            const int row = it * 2 + (tid >> 7), col = (tid & 127) * 8;
            uint4 o = uint4{0u, 0u, 0u, 0u};
            if (row < NSEQ) {
                const float* c = (row < 8 ? p.c_prompt + (size_t)row * D : p.c_sample + (size_t)(row - 8) * D) + col;
                const float4 a = *(const float4*)c, b = *(const float4*)(c + 4);
                float v[8] = {a.x, a.y, a.z, a.w, b.x, b.y, b.z, b.w};
#pragma unroll
                for (int j = 0; j < 8; ++j) v[j] = v[j] * sigmoidf_(v[j]);
                o = uint4{pack2(v[0], v[1]), pack2(v[2], v[3]), pack2(v[4], v[5]), pack2(v[6], v[7])};
            }
            *(uint4*)((bf16_t*)(ws + WS_AMOD) + (size_t)row * D + col) = o;
            continue;
        }
        it -= L_AMOD;
        {
            const size_t e = (size_t)it * 2048 + tid * 8;
            const int b = (int)(e / (11 * 512)), r = (int)(e % (11 * 512));
            const float* sp = p.state_pool + (size_t)b * 15 * 512 + 4 * 512 + r;
            float* d = p.out + O_POOLS + (size_t)b * 15 * 512 + r;
            *(float4*)d = *(const float4*)sp; *(float4*)(d + 4) = *(const float4*)(sp + 4);
        }
    }
}

struct EpiMod {
    float* mod; const float* bias;
    DEVI void operator()(const f32x4 (&acc)[2][2][4][2], const pg8::Unit& u, int wr, int wc, int fr, int fq) const {
        f32x4 bv[2][2];
#pragma unroll
        for (int bj = 0; bj < 2; ++bj)
#pragma unroll
            for (int n = 0; n < 2; ++n) bv[bj][n] = *(const f32x4*)(bias + PG8_COL(u, bj, n));
#pragma unroll
        for (int ai = 0; ai < 2; ++ai)
#pragma unroll
            for (int m = 0; m < 4; ++m) {
                const int row = PG8_ROW(u, ai, m);
#pragma unroll
                for (int bj = 0; bj < 2; ++bj)
#pragma unroll
                    for (int n = 0; n < 2; ++n) *(f32x4*)(mod + (size_t)row * NMOD + PG8_COL(u, bj, n)) = acc[ai][bj][m][n] + bv[bj][n];
            }
    }
};
struct EpiP {
    bf16_t* P; const float* bias; float* out;
    DEVI void operator()(const f32x4 (&acc)[2][2][4][2], const pg8::Unit& u, int wr, int wc, int fr, int fq) const {
        f32x4 bv[2][2];
#pragma unroll
        for (int bj = 0; bj < 2; ++bj)
#pragma unroll
            for (int n = 0; n < 2; ++n) bv[bj][n] = *(const f32x4*)(bias + PG8_COL(u, bj, n));
#pragma unroll
        for (int ai = 0; ai < 2; ++ai)
#pragma unroll
            for (int m = 0; m < 4; ++m) {
                const int row = PG8_ROW(u, ai, m);
                float* pool_dst = nullptr;
                if (u.pn < 2) {
                    if (row < NTP) { const int t = row & (SEQ - 1); if (t >= SEQ - 15) pool_dst = out + O_POOLP + ((size_t)(row >> 11) * 15 + (t - (SEQ - 15))) * 512; }
                    else { const int r = row - NTP; pool_dst = out + O_POOLS + ((size_t)(r >> 2) * 15 + 11 + (r & 3)) * 512; }
                }
#pragma unroll
                for (int bj = 0; bj < 2; ++bj) {
                    const int col = PG8_COL(u, bj, 0);
                    const f32x4 v0 = acc[ai][bj][m][0] + bv[bj][0], v1 = acc[ai][bj][m][1] + bv[bj][1];
                    *(u32x4*)(P + (size_t)row * NP + col) = u32x4{pack2(v0[0], v0[1]), pack2(v0[2], v0[3]), pack2(v1[0], v1[1]), pack2(v1[2], v1[3])};
                    if (pool_dst) { *(f32x4*)(pool_dst + col) = v0; *(f32x4*)(pool_dst + col + 4) = v1; }
                }
            }
    }
};
struct EpiOut {
    const float* xp; const float* xs; const float* mod; float* out;
    DEVI void operator()(const f32x4 (&acc)[2][2][4][2], const pg8::Unit& u, int wr, int wc, int fr, int fq) const {
        const float* g1 = mod + (size_t)((u.pm * 256) >> 11) * NMOD + 2048;
        f32x4 gv[2][2];
#pragma unroll
        for (int bj = 0; bj < 2; ++bj)
#pragma unroll
            for (int n = 0; n < 2; ++n) gv[bj][n] = *(const f32x4*)(g1 + PG8_COL(u, bj, n)) + 1.f;
#pragma unroll
        for (int ai = 0; ai < 2; ++ai)
#pragma unroll
            for (int bj = 0; bj < 2; ++bj) {
                f32x4 xv[4][2];
#pragma unroll
                for (int m = 0; m < 4; ++m)
#pragma unroll
                    for (int n = 0; n < 2; ++n) xv[m][n] = *(const f32x4*)(xp + (size_t)PG8_ROW(u, ai, m) * D + PG8_COL(u, bj, n));
#pragma unroll
                for (int m = 0; m < 4; ++m)
#pragma unroll
                    for (int n = 0; n < 2; ++n) *(f32x4*)(out + (size_t)PG8_ROW(u, ai, m) * D + PG8_COL(u, bj, n)) = xv[m][n] * ALPHA + gv[bj][n] * acc[ai][bj][m][n];
            }
    }
};
struct EpiQ {
    bf16_t* Q;
    DEVI void operator()(const f32x4 (&acc)[2][2][4][2], const pg8::Unit& u, int wr, int wc, int fr, int fq) const {
#pragma unroll
        for (int ai = 0; ai < 2; ++ai)
#pragma unroll
            for (int m = 0; m < 4; ++m) {
                const int row = PG8_ROW(u, ai, m);
#pragma unroll
                for (int bj = 0; bj < 2; ++bj) {
                    const int col = PG8_COL(u, bj, 0);
                    const f32x4 v0 = acc[ai][bj][m][0] * 1.f, v1 = acc[ai][bj][m][1] * 1.f;
                    *(u32x4*)(Q + (size_t)row * 2048 + col) = u32x4{pack2(v0[0], v0[1]), pack2(v0[2], v0[3]), pack2(v1[0], v1[1]), pack2(v1[2], v1[3])};
                }
            }
    }
};

DEVI void phase1(const Params& p, unsigned char* smem) {
    unsigned char* ws = p.ws;
    {
        pg8::Gemm g{(const bf16_t*)(ws + WS_AMOD), (const bf16_t*)(ws + WS_WTMOD), 256, NMOD, D, D};
        pg8::StaticOrder S; S.init(256, NMOD, (int)gridDim.x, (int)blockIdx.x);
        EpiMod E{(float*)(ws + WS_MOD), p.b_mod};
        pg8::gemm_phase(( LAS unsigned char*)smem, g, S, E);
    }
    const int tid = TID, lane = tid & 63, w = tid >> 6;
    {
        for (int ci = ((int)blockIdx.x - 24) * 2 + VHALF; ci >= 0 && ci < 4096; ci += NVB - 48) {
            {
            const bool isu = ci < 2048;
            const int row0 = (ci & 2047) * 8 + w * 2;
            const float* tab = isu ? p.u_tab : p.v_tab;
            unsigned char* dst = ws + (isu ? WS_UT : WS_VT);
            float* sc = (float*)(ws + (isu ? WS_USC : WS_VSC));
#pragma unroll
            for (int r = 0; r < 2; ++r) {
                const int row = row0 + r;
                const float* src = tab + (size_t)row * D + lane * 16;
                float v[16];
#pragma unroll
                for (int i = 0; i < 4; ++i) { const float4 t = *(const float4*)(src + i * 4); v[i * 4] = t.x; v[i * 4 + 1] = t.y; v[i * 4 + 2] = t.z; v[i * 4 + 3] = t.w; }
                float am = 0.f;
#pragma unroll
                for (int i = 0; i < 16; ++i) am = fmaxf(am, fabsf(v[i]));
#pragma unroll
                for (int o = 32; o > 0; o >>= 1) am = fmaxf(am, __shfl_xor(am, o));
                if (isu && !UFP4) {
                    const float scl = am > 0.f ? 224.f / am : 1.f;
                    if (lane == 0) sc[row] = am > 0.f ? am * (1.f / 224.f) : 1.f;
                    int wd[4];
#pragma unroll
                    for (int i = 0; i < 4; ++i) {
                        int t = __builtin_amdgcn_cvt_pk_fp8_f32(v[i * 4] * scl, v[i * 4 + 1] * scl, 0, false);
                        wd[i] = __builtin_amdgcn_cvt_pk_fp8_f32(v[i * 4 + 2] * scl, v[i * 4 + 3] * scl, t, true);
                    }
                    *(int4*)(dst + (size_t)row * D + lane * 16) = int4{wd[0], wd[1], wd[2], wd[3]};
                } else {
                    const float scl = am > 0.f ? 6.f / am : 1.f;
                    if (lane == 0) sc[row] = am > 0.f ? am * (1.f / 6.f) : 1.f;
                    unsigned d0 = 0u, d1 = 0u;
                    d0 = __builtin_amdgcn_cvt_scalef32_pk_fp4_f32(d0, v[0] * scl, v[1] * scl, 1.0f, 0);
                    d0 = __builtin_amdgcn_cvt_scalef32_pk_fp4_f32(d0, v[2] * scl, v[3] * scl, 1.0f, 1);
                    d0 = __builtin_amdgcn_cvt_scalef32_pk_fp4_f32(d0, v[4] * scl, v[5] * scl, 1.0f, 2);
                    d0 = __builtin_amdgcn_cvt_scalef32_pk_fp4_f32(d0, v[6] * scl, v[7] * scl, 1.0f, 3);
                    d1 = __builtin_amdgcn_cvt_scalef32_pk_fp4_f32(d1, v[8] * scl, v[9] * scl, 1.0f, 0);
                    d1 = __builtin_amdgcn_cvt_scalef32_pk_fp4_f32(d1, v[10] * scl, v[11] * scl, 1.0f, 1);
                    d1 = __builtin_amdgcn_cvt_scalef32_pk_fp4_f32(d1, v[12] * scl, v[13] * scl, 1.0f, 2);
                    d1 = __builtin_amdgcn_cvt_scalef32_pk_fp4_f32(d1, v[14] * scl, v[15] * scl, 1.0f, 3);
                    *(uint2*)(dst + (size_t)row * 512 + lane * 8) = uint2{d0, d1};
                }
            }
        }
    }
    }
}

DEVI void phase2(const Params& p, unsigned char* smem) {
    unsigned char* ws = p.ws;
    const int tid = threadIdx.x, lane = tid & 63, w = tid >> 6;
    const float* mod = (const float*)(ws + WS_MOD);
    bf16_t* u1 = (bf16_t*)(ws + WS_BUFA);
    float* gates = (float*)(ws + WS_GATES);
    float* Wg = (float*)smem;
    for (int k = tid; k < 1024; k += 512) {
        const float4 w0 = *(const float4*)(p.w_in + (size_t)k * DIN + NP), w1 = *(const float4*)(p.w_in + (size_t)k * DIN + NP + 4);
        Wg[k] = w0.x; Wg[1024 + k] = w0.y; Wg[2048 + k] = w0.z; Wg[3072 + k] = w0.w;
        Wg[4096 + k] = w1.x; Wg[5120 + k] = w1.y; Wg[6144 + k] = w1.z; Wg[7168 + k] = w1.w;
    }
    __syncthreads();
    const int nw = gridDim.x * 8;
    for (int tok0 = blockIdx.x * 8 + w; tok0 < NT; tok0 += 2 * nw) {
      float vv[2][16];
      const bool has2 = tok0 + nw < NT;
#pragma unroll
      for (int t = 0; t < 2; ++t) {
          const float* x = xrow_ptr(p, (t == 0 || has2) ? tok0 + t * nw : tok0);
#pragma unroll
          for (int i = 0; i < 4; ++i) { const float4 q4 = *(const float4*)(x + i * 256 + lane * 4); vv[t][i * 4] = q4.x; vv[t][i * 4 + 1] = q4.y; vv[t][i * 4 + 2] = q4.z; vv[t][i * 4 + 3] = q4.w; }
      }
#pragma unroll
      for (int t = 0; t < 2; ++t) {
        if (t == 1 && !has2) break;
        const int tok = tok0 + t * nw;
        const float* ms = mod + (size_t)seq_of(tok) * NMOD;
        float v[16];
#pragma unroll
        for (int i = 0; i < 16; ++i) v[i] = vv[t][i];
        float s = 0.f;
#pragma unroll
        for (int i = 0; i < 16; ++i) s += v[i];
        const float mean = wave_sum(s) * (1.f / 1024.f);
        float q = 0.f;
#pragma unroll
        for (int i = 0; i < 16; ++i) { v[i] -= mean; q += v[i] * v[i]; }
        const float rstd = rsqrtf(wave_sum(q) * (1.f / 1024.f) + LN_EPS);
        float g[8] = {0.f, 0.f, 0.f, 0.f, 0.f, 0.f, 0.f, 0.f};
#pragma unroll
        for (int i = 0; i < 4; ++i) {
            const int c = i * 256 + lane * 4;
            const float4 sh = *(const float4*)(ms + c), sc = *(const float4*)(ms + 1024 + c);
            float u[4];
            u[0] = v[i * 4] * rstd * (1.f + sc.x) + sh.x; u[1] = v[i * 4 + 1] * rstd * (1.f + sc.y) + sh.y;
            u[2] = v[i * 4 + 2] * rstd * (1.f + sc.z) + sh.z; u[3] = v[i * 4 + 3] * rstd * (1.f + sc.w) + sh.w;
            *(uint2*)(u1 + (size_t)tok * D + c) = uint2{pack2(u[0], u[1]), pack2(u[2], u[3])};
#pragma unroll
            for (int gg = 0; gg < 8; ++gg) {
                const float4 wv = *(const float4*)&Wg[gg * 1024 + c];
                g[gg] += u[0] * wv.x + u[1] * wv.y + u[2] * wv.z + u[3] * wv.w;
            }
        }
#pragma unroll
        for (int j = 0; j < 8; ++j) g[j] = wave_sum(g[j]);
        if (lane == 0) {
            const float4 b0 = *(const float4*)(p.b_in + NP), b1 = *(const float4*)(p.b_in + NP + 4);
            *(float4*)(gates + (size_t)tok * 8) = float4{g[0] + b0.x, g[1] + b0.y, g[2] + b0.z, g[3] + b0.w};
            *(float4*)(gates + (size_t)tok * 8 + 4) = float4{g[4] + b1.x, g[5] + b1.y, g[6] + b1.z, g[7] + b1.w};
        }
      }
    }
}

DEVI void phase3(const Params& p, unsigned char* smem) {
    unsigned char* ws = p.ws;
    const int lane = threadIdx.x & 63;
    pg8::Gemm g{(const bf16_t*)(ws + WS_BUFA), (const bf16_t*)(ws + WS_WTIN), NT, NP, D, D};
    pg8::StaticOrder S; S.init(NT, NP, (int)gridDim.x, (int)blockIdx.x);
    EpiP E{(bf16_t*)(ws + WS_P), p.b_in, p.out};
    pg8::gemm_phase((LAS unsigned char*)smem, g, S, E);
    if ((int)blockIdx.x >= (int)gridDim.x - 32 && (threadIdx.x >> 6) == 0) {
        const int bh = (int)blockIdx.x - ((int)gridDim.x - 32), b = bh >> 2, h = bh & 3;
        const float* gates = (const float*)(ws + WS_GATES);
        float* mst = (float*)(ws + WS_MST) + bh * 64;
        float m = 0.f;
        for (int c = 0; c < 32; ++c) {
            const int tok = b * SEQ + c * 64 + lane;
            const float gi = gates[(size_t)tok * 8 + h], gf = gates[(size_t)tok * 8 + 4 + h];
            const float bb = scan_sum_incl(logsigmoid(gf), lane);
            const float R = scan_max_incl(gi - bb, lane);
            const float B63 = __shfl(bb, 63), R63 = __shfl(R, 63);
            {
                const int ti = bh * 2048 + c * 64 + lane;
                ((float*)(ws + WS_GA))[ti] = B63 - bb + gi; ((float*)(ws + WS_BB))[ti] = bb;
                ((float*)(ws + WS_RR))[ti] = gi - bb; ((float*)(ws + WS_RPM))[ti] = R;
                if (lane == 0) ((float*)(ws + WS_BCH))[bh * 32 + c] = B63;
            }
            if (lane == 0) mst[c] = m;
            m = B63 + fmaxf(m, R63);
        }
        if (lane == 0) { mst[32] = m; p.out[O_MP + bh] = m; }
    }
}

#define LDS_BAR() do { asm volatile("s_waitcnt lgkmcnt(0)" ::: "memory"); __builtin_amdgcn_s_barrier(); asm volatile("" ::: "memory"); } while (0)
DEVI void p4_state_scan(const Params& p, unsigned char* smem, int it) {
    unsigned char* ws = p.ws;
    const int tid = TID, lane = tid & 63, w = tid >> 6, fr = lane & 15, fq = lane >> 4;
    const int bh = it >> 3, sl = it & 7, b = bh >> 2, h = bh & 3;
    bf16_t* Ks = (bf16_t*)smem;
    bf16_t* Vs = (bf16_t*)(smem + 64 * LDW * 2);
    float* gin = (float*)(smem + 64 * LDW * 2 + 64 * 24 * 2);
    const bf16_t* P = (const bf16_t*)(ws + WS_P);
    const float* gates = (const float*)(ws + WS_GATES);
    const float* mst = (const float*)(ws + WS_MST) + bh * 64;
    bf16_t* ST = (bf16_t*)(ws + WS_BUFB) + (size_t)bh * 32 * 16384;
    float* nst = (float*)(ws + WS_NST) + (size_t)bh * 32 * 128;
    f32x4 acc[2] = {f32x4{0.f, 0.f, 0.f, 0.f}, f32x4{0.f, 0.f, 0.f, 0.f}};
    float nacc = 0.f;
    u32x4 ka0, ka1, ka2, ka3, va = u32x4{0u, 0u, 0u, 0u}; float gia = 0.f, gfa = 0.f;
    u32x4 kb0, kb1, kb2, kb3, vb_ = u32x4{0u, 0u, 0u, 0u}; float gib = 0.f, gfb = 0.f;
    const int ks_ = tid >> 4, kc_ = tid & 15;
#define P4_PREFETCH(c, K0, K1, K2, K3, VR, GI, GF) do { const int _t0 = b * SEQ + (c) * 64; \
        { const bf16_t* _kp = P + (size_t)(_t0 + ks_) * NP + 1024 + h * 128 + kc_ * 8; \
          K0 = *(const u32x4*)(_kp); K1 = *(const u32x4*)(_kp + (size_t)16 * NP); K2 = *(const u32x4*)(_kp + (size_t)32 * NP); K3 = *(const u32x4*)(_kp + (size_t)48 * NP); } \
        if (tid < 128) VR = *(const u32x4*)(P + (size_t)(_t0 + (tid >> 1)) * NP + 1536 + h * 128 + sl * 16 + (tid & 1) * 8); \
        if (w == 0) { GI = ((const float*)(ws + WS_GA))[bh * 2048 + (c) * 64 + lane]; GF = ((const float*)(ws + WS_BCH))[bh * 32 + (c)]; } } while (0)
#define P4_STEP(c, K0, K1, K2, K3, VR, GI, GF) do { \
        if (w == 0) { \
            const float mc = mst[(c)], mn = mst[(c) + 1]; \
            gin[lane] = expf(GI - mn) * KSCALE; \
            if (lane == 0) gin[64] = expf(GF + mc - mn); \
        } \
        *(u32x4*)&Ks[ks_ * LDW + kc_ * 8] = K0; *(u32x4*)&Ks[(ks_ + 16) * LDW + kc_ * 8] = K1; \
        *(u32x4*)&Ks[(ks_ + 32) * LDW + kc_ * 8] = K2; *(u32x4*)&Ks[(ks_ + 48) * LDW + kc_ * 8] = K3; \
        const u32x4 v = VR; \
        LDS_BAR(); \
        if ((c) + 2 < 32) P4_PREFETCH((c) + 2, K0, K1, K2, K3, VR, GI, GF); \
        { \
            bf16_t* STc = ST + (size_t)(c) * 16384; \
            _Pragma("unroll") for (int mt = 0; mt < 2; ++mt) { \
                const int d0 = (w * 2 + mt) * 16 + fq * 4, e = sl * 16 + fr; \
                *(uint2*)(STc + e * 128 + d0) = uint2{pack2(acc[mt][0], acc[mt][1]), pack2(acc[mt][2], acc[mt][3])}; \
            } \
            if (w == 0 && lane < 16) nst[(c) * 128 + sl * 16 + lane] = nacc; \
        } \
        const float gprev = gin[64]; \
        if (tid < 128) { \
            const int s_ = tid >> 1, hf = tid & 1; \
            const float g = gin[s_]; \
            *(uint4*)&Vs[s_ * 24 + hf * 8] = uint4{pack2(bf_lo(v.x) * g, bf_hi(v.x) * g), pack2(bf_lo(v.y) * g, bf_hi(v.y) * g), \
                                                    pack2(bf_lo(v.z) * g, bf_hi(v.z) * g), pack2(bf_lo(v.w) * g, bf_hi(v.w) * g)}; \
        } \
        if (w == 0) { \
            const int d = sl * 16 + fr; \
            float a = 0.f; \
            _Pragma("unroll") for (int s_ = 0; s_ < 16; ++s_) a += bf1(Ks[(fq * 16 + s_) * LDW + d]) * gin[fq * 16 + s_]; \
            nacc = gprev * nacc + sumq(a); \
        } \
        LDS_BAR(); \
        _Pragma("unroll") for (int mt = 0; mt < 2; ++mt) { acc[mt][0] *= gprev; acc[mt][1] *= gprev; acc[mt][2] *= gprev; acc[mt][3] *= gprev; } \
        _Pragma("unroll") for (int ks = 0; ks < 2; ++ks) { \
            const bf16x8 vfr = tr_frag(Vs, 24, ks * 32, 0, lane); \
            _Pragma("unroll") for (int mt = 0; mt < 2; ++mt) { \
                const bf16x8 ka = tr_frag(Ks, LDW, ks * 32, (w * 2 + mt) * 16, lane); \
                acc[mt] = __builtin_amdgcn_mfma_f32_16x16x32_bf16(ka, vfr, acc[mt], 0, 0, 0); \
            } \
        } \
        LDS_BAR(); } while (0)
    P4_PREFETCH(0, ka0, ka1, ka2, ka3, va, gia, gfa);
    P4_PREFETCH(1, kb0, kb1, kb2, kb3, vb_, gib, gfb);
    for (int c = 0; c < 32; c += 2) {
        P4_STEP(c, ka0, ka1, ka2, ka3, va, gia, gfa);
        P4_STEP(c + 1, kb0, kb1, kb2, kb3, vb_, gib, gfb);
    }
#undef P4_STEP
#undef P4_PREFETCH
    float* Cp = p.out + O_CP + (size_t)bh * 16384;
#pragma unroll
    for (int mt = 0; mt < 2; ++mt)
#pragma unroll
        for (int j = 0; j < 4; ++j) Cp[((w * 2 + mt) * 16 + fq * 4 + j) * 128 + sl * 16 + fr] = acc[mt][j];
    if (w == 0 && lane < 16) p.out[O_NP + bh * 128 + sl * 16 + lane] = nacc;
}

DEVI void p4_sample(const Params& p, unsigned char* smem, int it) {
    unsigned char* ws = p.ws;
    const int tid = TID, lane = tid & 63, w = tid >> 6;
    const int b = it >> 2, h = it & 3;
    float* qs = (float*)smem;
    float* kg = qs + 512;
    float* vs = kg + 512;
    float* ksc = vs + 512;
    float* qS = ksc + 512;
    float* Pm = qS + 1024;
    float* qn = Pm + 16;
    const bf16_t* P = (const bf16_t*)(ws + WS_P);
    const float* gates = (const float*)(ws + WS_GATES);
    const int tok0 = NTP + b * 4;
    float gi[4], bb[4], mt_[4];
    const float m0 = p.state_m[b * 4 + h];
    {
        float cum = 0.f, R = -INFINITY;
#pragma unroll
        for (int s = 0; s < 4; ++s) {
            gi[s] = gates[(size_t)(tok0 + s) * 8 + h];
            cum += logsigmoid(gates[(size_t)(tok0 + s) * 8 + 4 + h]);
            bb[s] = cum; R = fmaxf(R, gi[s] - cum);
            mt_[s] = cum + fmaxf(m0, R);
        }
    }
    const float mnew = mt_[3];
    const float gprev = expf(bb[3] + m0 - mnew);
    float gin[4];
#pragma unroll
    for (int s = 0; s < 4; ++s) gin[s] = expf(bb[3] - bb[s] + gi[s] - mnew);
    {
        const int t = tid >> 6, dd = (tid & 63) * 2;
        const bf16_t* row = P + (size_t)(tok0 + t) * NP + h * 128 + dd;
        const unsigned uq = *(const unsigned*)(row + 512), uk = *(const unsigned*)(row + 1024), uv = *(const unsigned*)(row + 1536);
        float g = gin[0]; g = t == 1 ? gin[1] : g; g = t == 2 ? gin[2] : g; g = t == 3 ? gin[3] : g;
        qs[t * 128 + dd] = bf_lo(uq); qs[t * 128 + dd + 1] = bf_hi(uq);
        const float k0 = bf_lo(uk) * KSCALE, k1 = bf_hi(uk) * KSCALE;
        ksc[t * 128 + dd] = k0; ksc[t * 128 + dd + 1] = k1;
        kg[t * 128 + dd] = k0 * g; kg[t * 128 + dd + 1] = k1 * g;
        vs[t * 128 + dd] = bf_lo(uv); vs[t * 128 + dd + 1] = bf_hi(uv);
    }
    __syncthreads();
    const int e = tid & 127, dh = tid >> 7;
    const float* S0 = p.state_C + (size_t)(b * 4 + h) * 16384;
    float* Cs = p.out + O_CS + (size_t)(b * 4 + h) * 16384;
    const float v0 = vs[e], v1 = vs[128 + e], v2 = vs[256 + e], v3 = vs[384 + e];
    float a0 = 0.f, a1 = 0.f, a2 = 0.f, a3 = 0.f;
    for (int hh = 0; hh < 4; ++hh) {
    float Sv[16];
#pragma unroll
    for (int i = 0; i < 16; ++i) Sv[i] = S0[(dh * 64 + hh * 16 + i) * 128 + e];
#pragma unroll
    for (int i = 0; i < 16; ++i) {
        const int d = dh * 64 + hh * 16 + i;
        const float S = Sv[i];
        a0 += qs[d] * S; a1 += qs[128 + d] * S; a2 += qs[256 + d] * S; a3 += qs[384 + d] * S;
        Cs[d * 128 + e] = gprev * S + kg[d] * v0 + kg[128 + d] * v1 + kg[256 + d] * v2 + kg[384 + d] * v3;
    }
    }
    qS[(dh * 4 + 0) * 128 + e] = a0; qS[(dh * 4 + 1) * 128 + e] = a1; qS[(dh * 4 + 2) * 128 + e] = a2; qS[(dh * 4 + 3) * 128 + e] = a3;
    {
        const int t = w;
        const float* n0 = p.state_n + (size_t)(b * 4 + h) * 128;
        const float q0 = qs[t * 128 + lane], q1 = qs[t * 128 + 64 + lane];
        const float qn_ = wave_sum(q0 * n0[lane] + q1 * n0[64 + lane]);
        if (lane == 0) qn[t] = qn_;
#pragma unroll
        for (int s = 0; s < 4; ++s) {
            const float d = wave_sum(q0 * ksc[s * 128 + lane] + q1 * ksc[s * 128 + 64 + lane]);
            if (lane == 0) Pm[t * 4 + s] = (s <= t) ? d * expf(bb[t] - bb[s] + gi[s] - mt_[t]) : 0.f;
        }
        if (t == 0) {
            const float n_a = gprev * n0[lane] + kg[lane] + kg[128 + lane] + kg[256 + lane] + kg[384 + lane];
            const float n_b = gprev * n0[64 + lane] + kg[64 + lane] + kg[192 + lane] + kg[320 + lane] + kg[448 + lane];
            p.out[O_NS + (size_t)(b * 4 + h) * 128 + lane] = n_a;
            p.out[O_NS + (size_t)(b * 4 + h) * 128 + 64 + lane] = n_b;
            if (lane == 0) p.out[O_MS + b * 4 + h] = mnew;
        }
    }
    __syncthreads();
    {
        const int t = w;
        const float wprev = expf(bb[t] + m0 - mt_[t]);
        const float p0 = Pm[t * 4], p1 = Pm[t * 4 + 1], p2 = Pm[t * 4 + 2], p3 = Pm[t * 4 + 3];
        const float den = wprev * qn[t] + p0 + p1 + p2 + p3;
        const float inv = 1.f / fmaxf(fabsf(den), expf(-mt_[t]));
        float hv[2];
#pragma unroll
        for (int r = 0; r < 2; ++r) {
            const int ee = lane + 64 * r;
            const float num = wprev * (qS[t * 128 + ee] + qS[(4 + t) * 128 + ee]) + p0 * vs[ee] + p1 * vs[128 + ee] + p2 * vs[256 + ee] + p3 * vs[384 + ee];
            hv[r] = num * inv;
        }
        const float mean = wave_sum(hv[0] + hv[1]) * (1.f / 128.f);
        const float c0 = hv[0] - mean, c1 = hv[1] - mean;
        const float rstd = rsqrtf(wave_sum(c0 * c0 + c1 * c1) * (1.f / 128.f) + LN_EPS);
        bf16_t* ym = (bf16_t*)(ws + WS_BUFA) + (size_t)(tok0 + t) * D + 512 + h * 128;
        const bf16_t* orow = P + (size_t)(tok0 + t) * NP + 2048 + h * 128;
#pragma unroll
        for (int r = 0; r < 2; ++r) {
            const int ee = lane + 64 * r;
            const float y = (r ? c1 : c0) * rstd * p.mh_norm_g[h * 128 + ee] * sigmoidf_(bf1(orow[ee]));
            ym[ee] = (bf16_t)(pack2(y, 0.f) & 0xFFFFu);
        }
    }
    __syncthreads();
}

DEVI void p4_pool(const Params& p, unsigned char* smem, int it) {
    unsigned char* ws = p.ws;
    const int tid = TID, lane = tid & 63, w = tid >> 6, wr = w >> 1, wc = w & 1, fr = lane & 15, fq = lane >> 4;
    const int tt = it >> 2, g = it & 3, win = 2 << g;
    bf16_t* Ad = (bf16_t*)smem;
    bf16_t* Bw = (bf16_t*)(smem + 128 * LDW * 2);
    const bf16_t* P = (const bf16_t*)(ws + WS_P);
#pragma unroll
    for (int i = 0; i < 8; ++i) {
        const int ch = tid + i * 256, r = ch >> 4, kc = ch & 15;
        *(uint4*)&Bw[r * LDW + kc * 8] = *(const uint4*)((const bf16_t*)(ws + WS_WTPOOL) + g * 16384 + r * 128 + kc * 8);
    }
    const int c4 = (tid & 31) * 4;
    if (tt < 128) {
        const int r0 = (tid >> 5) * 16;
        const int tokb = tt * 128 + r0;
        const int t0 = tokb & (SEQ - 1);
        const bf16_t* col = P + g * 128 + c4;
        float s0 = 0.f, s1 = 0.f, s2 = 0.f, s3 = 0.f;
        {
            uint2 zh[15];
#pragma unroll
            for (int k = 1; k < 16; ++k) zh[k - 1] = (k < win && t0 - k >= 0) ? *(const uint2*)(col + (size_t)(tokb - k) * NP) : uint2{0u, 0u};
#pragma unroll
            for (int k = 0; k < 15; ++k) { s0 += bf_lo(zh[k].x); s1 += bf_hi(zh[k].x); s2 += bf_lo(zh[k].y); s3 += bf_hi(zh[k].y); }
        }
        for (int hp = 0; hp < 2; ++hp) {
            uint2 zz[8], zo[8];
#pragma unroll
            for (int i = 0; i < 8; ++i) {
                const int ii = hp * 8 + i;
                zz[i] = *(const uint2*)(col + (size_t)(tokb + ii) * NP);
                zo[i] = (t0 + ii - win + 1 >= 0) ? *(const uint2*)(col + (size_t)(tokb + ii - win + 1) * NP) : uint2{0u, 0u};
            }
#pragma unroll
            for (int i = 0; i < 8; ++i) {
                const int ii = hp * 8 + i, t = t0 + ii;
                const float u0 = bf_lo(zz[i].x), u1 = bf_hi(zz[i].x), u2 = bf_lo(zz[i].y), u3 = bf_hi(zz[i].y);
                s0 += u0; s1 += u1; s2 += u2; s3 += u3;
                const float ic = 1.f / (float)min(t + 1, win);
                *(uint2*)&Ad[(r0 + ii) * LDW + c4] = uint2{pack2(s0 * ic - u0, s1 * ic - u1), pack2(s2 * ic - u2, s3 * ic - u3)};
                s0 -= bf_lo(zo[i].x); s1 -= bf_hi(zo[i].x); s2 -= bf_lo(zo[i].y); s3 -= bf_hi(zo[i].y);
            }
        }
    } else {
        const float ic = 1.f / (float)win;
        for (int i = 0; i < 4; ++i) {
            const int sq = (tid >> 5) * 4 + i;
            const int b = (tt - 128) * 32 + sq;
            const float* buf = p.state_pool + (size_t)b * 15 * 512 + g * 128 + c4;
            const bf16_t* col = P + (size_t)(NTP + b * 4) * NP + g * 128 + c4;
            float s0 = 0.f, s1 = 0.f, s2 = 0.f, s3 = 0.f;
            for (int k = 1; k < win; ++k) { const float4 z = *(const float4*)(buf + (15 - k) * 512); s0 += z.x; s1 += z.y; s2 += z.z; s3 += z.w; }
            for (int t = 0; t < 4; ++t) {
                const uint2 z = *(const uint2*)(col + (size_t)t * NP);
                const float u0 = bf_lo(z.x), u1 = bf_hi(z.x), u2 = bf_lo(z.y), u3 = bf_hi(z.y);
                s0 += u0; s1 += u1; s2 += u2; s3 += u3;
                *(uint2*)&Ad[(sq * 4 + t) * LDW + c4] = uint2{pack2(s0 * ic - u0, s1 * ic - u1), pack2(s2 * ic - u2, s3 * ic - u3)};
                const int zi = 15 + t - win + 1;
                if (zi < 15) { const float4 zo = *(const float4*)(buf + zi * 512); s0 -= zo.x; s1 -= zo.y; s2 -= zo.z; s3 -= zo.w; }
                else { const uint2 zo = *(const uint2*)(col + (size_t)(zi - 15) * NP); s0 -= bf_lo(zo.x); s1 -= bf_hi(zo.x); s2 -= bf_lo(zo.y); s3 -= bf_hi(zo.y); }
            }
        }
    }
    __syncthreads();
    f32x4 acc[4][4];
    mma_lds128(Ad, Bw, acc);
    bf16_t* ym = (bf16_t*)(ws + WS_BUFA);
#pragma unroll
    for (int m = 0; m < 4; ++m) {
        const int row = tt * 128 + wr * 64 + m * 16 + fr;
#pragma unroll
        for (int n = 0; n < 4; ++n) {
            const int col = g * 128 + wc * 64 + n * 16 + fq * 4;
            const float4 ps = *(const float4*)(p.pool_scale + col);
            *(uint2*)(ym + (size_t)row * D + col) = uint2{pack2(acc[m][n][0] * ps.x, acc[m][n][1] * ps.y), pack2(acc[m][n][2] * ps.z, acc[m][n][3] * ps.w)};
        }
    }
    __syncthreads();
}

DEVI void phase4(const Params& p, unsigned char* smem_all) {
    unsigned char* smem = smem_all + VHALF * SMEM_HALF;
    for (int it0 = (int)blockIdx.x * 2; it0 < 512; it0 += NVB) p4_sample(p, smem, it0 + VHALF);
    const int nscan = min(128, (int)gridDim.x / 2);
    if ((int)blockIdx.x < nscan) { for (int it0 = (int)blockIdx.x * 2; it0 < 256; it0 += nscan * 2) p4_state_scan(p, smem, it0 + VHALF); return; }
    const int rb = (int)blockIdx.x - nscan, nrb = ((int)gridDim.x - nscan) * 2;
    for (int it0 = rb * 2; it0 < 528; it0 += nrb) p4_pool(p, smem, it0 + VHALF);
}

DEVI void phase5(const Params& p, unsigned char* smem_all) {
    unsigned char* smem = smem_all + VHALF * SMEM_HALF;
    unsigned char* ws = p.ws;
    const int tid = TID, lane = tid & 63, w = tid >> 6, fr = lane & 15, fq = lane >> 4;
    bf16_t* Ks = (bf16_t*)smem;
    bf16_t* Vs = (bf16_t*)(smem + 64 * LDW * 2);
    bf16_t* Ps = (bf16_t*)(smem + 2 * 64 * LDW * 2) + w * 16 * LDT;
    const bf16_t* P = (const bf16_t*)(ws + WS_P);
    const float* gates = (const float*)(ws + WS_GATES);
    for (int it0 = blockIdx.x * 2; it0 < 1024; it0 += NVB) {
        const int item = it0 + VHALF;
        const int bh = item >> 5, c = item & 31, b = bh >> 2, h = bh & 3;
        const int tok0 = b * SEQ + c * 64;
        const float gi = gates[(size_t)(tok0 + lane) * 8 + h], gf = gates[(size_t)(tok0 + lane) * 8 + 4 + h];
        const float bb = scan_sum_incl(logsigmoid(gf), lane);
        const float rr = gi - bb;
        const float R = scan_max_incl(rr, lane);
        const float mc = ((const float*)(ws + WS_MST))[bh * 64 + c];
        const float mt_all = bb + fmaxf(mc, R);
        const int trow = w * 16 + fr;
        const float bt = __shfl(bb, trow), mt = __shfl(mt_all, trow);
#pragma unroll
        for (int i = 0; i < 4; ++i) {
            const int ch = tid + i * 256, s = ch >> 4, kc = ch & 15;
            const bf16_t* src = P + (size_t)(tok0 + s) * NP + h * 128 + kc * 8;
            *(uint4*)&Ks[s * LDW + kc * 8] = *(const uint4*)(src + 1024);
            *(uint4*)&Vs[s * LDW + kc * 8] = *(const uint4*)(src + 1536);
        }
        bf16x8 qa[4];
        const bf16_t* qrow = P + (size_t)(tok0 + trow) * NP + 512 + h * 128 + fq * 8;
#pragma unroll
        for (int ks = 0; ks < 4; ++ks) qa[ks] = *(const bf16x8*)(qrow + ks * 32);
        __syncthreads();
        f32x4 sacc[4];
#pragma unroll
        for (int nt = 0; nt < 4; ++nt) {
            sacc[nt] = f32x4{0.f, 0.f, 0.f, 0.f};
#pragma unroll
            for (int ks = 0; ks < 4; ++ks) {
                const bf16x8 kb = *(const bf16x8*)&Ks[(nt * 16 + fr) * LDW + ks * 32 + fq * 8];
                sacc[nt] = __builtin_amdgcn_mfma_f32_16x16x32_bf16(kb, qa[ks], sacc[nt], 0, 0, 0);
            }
        }
        float rowsum = 0.f;
#pragma unroll
        for (int nt = 0; nt < 4; ++nt) {
            float pv[4];
#pragma unroll
            for (int j = 0; j < 4; ++j) {
                const int s = nt * 16 + fq * 4 + j;
                const float rs = __shfl(rr, s);
                const float dd = (s <= trow) ? expf(bt - mt + rs) : 0.f;
                pv[j] = sacc[nt][j] * KSCALE * dd;
                rowsum += pv[j];
            }
            *(uint2*)&Ps[fr * LDT + nt * 16 + fq * 4] = uint2{pack2(pv[0], pv[1]), pack2(pv[2], pv[3])};
        }
        rowsum = sumq(rowsum);
        float qn = 0.f;
        {
            const float* nc = (const float*)(ws + WS_NST) + (size_t)(bh * 32 + c) * 128 + fq * 8;
#pragma unroll
            for (int ks = 0; ks < 4; ++ks) {
                const float4 n0 = *(const float4*)(nc + ks * 32), n1 = *(const float4*)(nc + ks * 32 + 4);
                const u32x4 qq = __builtin_bit_cast(u32x4, qa[ks]);
                qn += bf_lo(qq.x) * n0.x + bf_hi(qq.x) * n0.y + bf_lo(qq.y) * n0.z + bf_hi(qq.y) * n0.w
                    + bf_lo(qq.z) * n1.x + bf_hi(qq.z) * n1.y + bf_lo(qq.w) * n1.z + bf_hi(qq.w) * n1.w;
            }
            qn = sumq(qn);
        }
        f32x4 oacc[8];
        const bf16_t* STc = (const bf16_t*)(ws + WS_BUFB) + (size_t)(bh * 32 + c) * 16384;
#pragma unroll
        for (int nt = 0; nt < 8; ++nt) {
            oacc[nt] = f32x4{0.f, 0.f, 0.f, 0.f};
#pragma unroll
            for (int ks = 0; ks < 4; ++ks) {
                const bf16x8 sb = *(const bf16x8*)(STc + (nt * 16 + fr) * 128 + ks * 32 + fq * 8);
                oacc[nt] = __builtin_amdgcn_mfma_f32_16x16x32_bf16(sb, qa[ks], oacc[nt], 0, 0, 0);
            }
            if (nt & 1) asm volatile("" ::: "memory");
        }
        const float wprev = expf(bt + mc - mt);
#pragma unroll
        for (int nt = 0; nt < 8; ++nt) { oacc[nt][0] *= wprev; oacc[nt][1] *= wprev; oacc[nt][2] *= wprev; oacc[nt][3] *= wprev; }
        __syncthreads();
#pragma unroll
        for (int ks = 0; ks < 2; ++ks) {
            const bf16x8 pf = *(const bf16x8*)&Ps[fr * LDT + ks * 32 + fq * 8];
#pragma unroll
            for (int nt = 0; nt < 8; ++nt) {
                const bf16x8 vt = tr_frag(Vs, LDW, ks * 32, nt * 16, lane);
                oacc[nt] = __builtin_amdgcn_mfma_f32_16x16x32_bf16(vt, pf, oacc[nt], 0, 0, 0);
            }
        }
        const float den = wprev * qn + rowsum;
        const float inv = 1.f / fmaxf(fabsf(den), expf(-mt));
        float s1 = 0.f;
#pragma unroll
        for (int nt = 0; nt < 8; ++nt)
#pragma unroll
            for (int j = 0; j < 4; ++j) { oacc[nt][j] *= inv; s1 += oacc[nt][j]; }
        const float mean = sumq(s1) * (1.f / 128.f);
        float s2 = 0.f;
#pragma unroll
        for (int nt = 0; nt < 8; ++nt)
#pragma unroll
            for (int j = 0; j < 4; ++j) { oacc[nt][j] -= mean; s2 += oacc[nt][j] * oacc[nt][j]; }
        const float rstd = rsqrtf(sumq(s2) * (1.f / 128.f) + LN_EPS);
        bf16_t* ym = (bf16_t*)(ws + WS_BUFA) + (size_t)(tok0 + trow) * D + 512 + h * 128;
        const bf16_t* orow = P + (size_t)(tok0 + trow) * NP + 2048 + h * 128;
#pragma unroll
        for (int nt = 0; nt < 8; ++nt) {
            const int e = nt * 16 + fq * 4;
            const float4 gg = *(const float4*)(p.mh_norm_g + h * 128 + e);
            const uint2 oo = *(const uint2*)(orow + e);
            const float y0 = oacc[nt][0] * rstd * gg.x * sigmoidf_(bf_lo(oo.x)), y1 = oacc[nt][1] * rstd * gg.y * sigmoidf_(bf_hi(oo.x));
            const float y2 = oacc[nt][2] * rstd * gg.z * sigmoidf_(bf_lo(oo.y)), y3 = oacc[nt][3] * rstd * gg.w * sigmoidf_(bf_hi(oo.y));
            *(uint2*)(ym + e) = uint2{pack2(y0, y1), pack2(y2, y3)};
        }
        __syncthreads();
    }
}

struct EpiOutPart {
    const float* xs; const float* mod; float* out; float* part; int ks;
    DEVI void operator()(const f32x4 (&acc)[2][2][4][2], const pg8::Unit& u, int wr, int wc, int fr, int fq) const {
#pragma unroll
        for (int ai = 0; ai < 2; ++ai)
#pragma unroll
            for (int m = 0; m < 4; ++m) {
                const int row = PG8_ROW(u, ai, m), rs = row - NTP;
                const float* x = xs + (size_t)rs * D;
                const float* g1 = mod + (size_t)seq_of(row) * NMOD + 2048;
                float* dst = ks == 0 ? out + (size_t)row * D : part + ((size_t)(ks - 1) * NTS + rs) * D;
                f32x4 xv[2][2], gv[2][2];
#pragma unroll
                for (int bj = 0; bj < 2; ++bj)
#pragma unroll
                    for (int n = 0; n < 2; ++n) { const int col = PG8_COL(u, bj, n); gv[bj][n] = *(const f32x4*)(g1 + col); xv[bj][n] = ks == 0 ? *(const f32x4*)(x + col) * ALPHA : f32x4{0.f, 0.f, 0.f, 0.f}; }
#pragma unroll
                for (int bj = 0; bj < 2; ++bj)
#pragma unroll
                    for (int n = 0; n < 2; ++n) *(f32x4*)(dst + PG8_COL(u, bj, n)) = xv[bj][n] + (gv[bj][n] + 1.f) * acc[ai][bj][m][n];
            }
    }
};

DEVI void phase6(const Params& p, unsigned char* smem) {
    unsigned char* ws = p.ws;
    {
        pg8::Gemm g{(const bf16_t*)(ws + WS_BUFA), (const bf16_t*)(ws + WS_WTOUT), NTP, D, D, D};
        pg8::StaticOrder S; S.init(NTP, D, (int)gridDim.x, (int)blockIdx.x);
        EpiOut E{p.x_prompt, p.x_sample, (const float*)(ws + WS_MOD), p.out};
        pg8::gemm_phase((LAS unsigned char*)smem, g, S, E);
    }
    {
        const int q = (int)blockIdx.x - ((int)gridDim.x - 32);
        const int qq = q < 0 ? 0 : q, ks = qq & 3;
        pg8::Gemm g{(const bf16_t*)(ws + WS_BUFA) + ks * 256, (const bf16_t*)(ws + WS_WTOUT) + ks * 256, NT, D, 256, D};
        pg8::OneUnit S{q >= 0, pg8::Unit{64 + (qq >> 4), (qq >> 2) & 3}};
        EpiOutPart E{p.x_sample, (const float*)(ws + WS_MOD), p.out, (float*)(ws + WS_PART), ks};
        pg8::gemm_phase((LAS unsigned char*)smem, g, S, E);
    }
}

DEVI void phase7(const Params& p) {
    unsigned char* ws = p.ws;
    const int tid = threadIdx.x, lane = tid & 63, w = tid >> 6;
    const float* mod = (const float*)(ws + WS_MOD);
    bf16_t* u2 = (bf16_t*)(ws + WS_BUFB);
    const int nw = gridDim.x * 8;
    for (int tok0 = blockIdx.x * 8 + w; tok0 < NT; tok0 += 2 * nw) {
        float v[2][16];
        const bool has2 = tok0 + nw < NT;
#pragma unroll
        for (int t = 0; t < 2; ++t) {
            const int tok = (t == 0 || has2) ? tok0 + t * nw : tok0;
            const float* x = p.out + (size_t)tok * D;
#pragma unroll
            for (int i = 0; i < 4; ++i) { const float4 q4 = *(const float4*)(x + i * 256 + lane * 4); v[t][i * 4] = q4.x; v[t][i * 4 + 1] = q4.y; v[t][i * 4 + 2] = q4.z; v[t][i * 4 + 3] = q4.w; }
            if (tok >= NTP) {
                const float* pp = (const float*)(ws + WS_PART) + (size_t)(tok - NTP) * D;
#pragma unroll
                for (int k = 0; k < 3; ++k)
#pragma unroll
                    for (int i = 0; i < 4; ++i) { const float4 q4 = *(const float4*)(pp + (size_t)k * NTS * D + i * 256 + lane * 4); v[t][i * 4] += q4.x; v[t][i * 4 + 1] += q4.y; v[t][i * 4 + 2] += q4.z; v[t][i * 4 + 3] += q4.w; }
            }
        }
#pragma unroll
        for (int t = 0; t < 2; ++t) {
            if (t == 1 && !has2) break;
            const int tok = tok0 + t * nw;
            float* x = p.out + (size_t)tok * D;
            const float* ms = mod + (size_t)seq_of(tok) * NMOD;
            float s = 0.f;
#pragma unroll
            for (int i = 0; i < 16; ++i) s += v[t][i];
            float mean = wave_sum(s) * (1.f / 1024.f);
            float q = 0.f;
#pragma unroll
            for (int i = 0; i < 16; ++i) { v[t][i] -= mean; q += v[t][i] * v[t][i]; }
            float rstd = rsqrtf(wave_sum(q) * (1.f / 1024.f) + LN_EPS);
            s = 0.f;
#pragma unroll
            for (int i = 0; i < 4; ++i) {
                const int c = i * 256 + lane * 4;
                const float4 g = *(const float4*)(p.ln1_g + c), bq = *(const float4*)(p.ln1_b + c);
                v[t][i * 4] = v[t][i * 4] * rstd * g.x + bq.x; v[t][i * 4 + 1] = v[t][i * 4 + 1] * rstd * g.y + bq.y;
                v[t][i * 4 + 2] = v[t][i * 4 + 2] * rstd * g.z + bq.z; v[t][i * 4 + 3] = v[t][i * 4 + 3] * rstd * g.w + bq.w;
                *(float4*)(x + c) = float4{v[t][i * 4], v[t][i * 4 + 1], v[t][i * 4 + 2], v[t][i * 4 + 3]};
                s += v[t][i * 4] + v[t][i * 4 + 1] + v[t][i * 4 + 2] + v[t][i * 4 + 3];
            }
            mean = wave_sum(s) * (1.f / 1024.f);
            q = 0.f;
#pragma unroll
            for (int i = 0; i < 16; ++i) { v[t][i] -= mean; q += v[t][i] * v[t][i]; }
            rstd = rsqrtf(wave_sum(q) * (1.f / 1024.f) + LN_EPS);
#pragma unroll
            for (int i = 0; i < 4; ++i) {
                const int c = i * 256 + lane * 4;
                const float4 sh = *(const float4*)(ms + 3072 + c), sc = *(const float4*)(ms + 4096 + c);
                *(uint2*)(u2 + (size_t)tok * D + c) = uint2{pack2(v[t][i * 4] * rstd * (1.f + sc.x) + sh.x, v[t][i * 4 + 1] * rstd * (1.f + sc.y) + sh.y),
                                                            pack2(v[t][i * 4 + 2] * rstd * (1.f + sc.z) + sh.z, v[t][i * 4 + 3] * rstd * (1.f + sc.w) + sh.w)};
            }
        }
    }
}

DEVI void combine_pair(const int* k0, const int* k1, int* ed, float* gd) {
        int ka[16], kb[16];
#pragma unroll
        for (int i = 0; i < 4; ++i) {
            const int4 a = *(const int4*)(k0 + i * 4), b = *(const int4*)(k1 + i * 4);
            ka[i * 4] = a.x; ka[i * 4 + 1] = a.y; ka[i * 4 + 2] = a.z; ka[i * 4 + 3] = a.w;
            kb[i * 4] = b.x; kb[i * 4 + 1] = b.y; kb[i * 4 + 2] = b.z; kb[i * 4 + 3] = b.w;
        }
        float va[16], vb[16];
#pragma unroll
        for (int i = 0; i < 16; ++i) { va[i] = key_val(ka[i], 0x7F); vb[i] = key_val(kb[i], 0x7F); }
        int R[16];
#define CAND(i, j) key_enc(va[i] + vb[j], ((i) << 4) | (j), 0xFF)
        {
            int N0[16] = {CAND(0,0), CAND(0,1), CAND(0,2), CAND(0,3), CAND(0,4), CAND(0,5), CAND(0,6), CAND(0,7), CAND(0,8), CAND(0,9), CAND(0,10), CAND(0,11), CAND(0,12), CAND(0,13), CAND(0,14), CAND(0,15)};
            bitonic_sort_desc<16>(N0);
#pragma unroll
            for (int i = 0; i < 16; ++i) R[i] = N0[i];
        }
        {
            int N1[16] = {CAND(1,0), CAND(1,1), CAND(1,2), CAND(1,3), CAND(1,4), CAND(1,5), CAND(1,6), CAND(1,7), CAND(2,0), CAND(2,1), CAND(2,2), CAND(2,3), CAND(2,4), CAND(3,0), CAND(3,1), CAND(3,2)};
            bitonic_sort_desc<16>(N1);
#pragma unroll
            for (int i = 0; i < 16; ++i) R[i] = max(R[i], N1[15 - i]);
            bitonic_merge16_desc(R);
        }
        {
            int N2[16] = {CAND(3,3), CAND(4,0), CAND(4,1), CAND(4,2), CAND(5,0), CAND(5,1), CAND(6,0), CAND(6,1), CAND(7,0), CAND(7,1), CAND(8,0), CAND(9,0), CAND(10,0), CAND(11,0), CAND(12,0), CAND(13,0)};
            bitonic_sort_desc<16>(N2);
#pragma unroll
            for (int i = 0; i < 16; ++i) R[i] = max(R[i], N2[15 - i]);
            bitonic_merge16_desc(R);
        }
        {
            int N3[16];
            N3[0] = max(CAND(14,0), CAND(15,0)); N3[1] = min(CAND(14,0), CAND(15,0));
#pragma unroll
            for (int i = 2; i < 16; ++i) N3[i] = (int)0x80000000;
#pragma unroll
            for (int i = 0; i < 16; ++i) R[i] = max(R[i], N3[15 - i]);
            bitonic_merge16_desc(R);
        }
#undef CAND
        float val[16]; int ex[16];
#pragma unroll
        for (int k = 0; k < 16; ++k) {
            const int i = (R[k] >> 4) & 15, j = R[k] & 15;
            const int a = k0[i], b = k1[j];
            val[k] = key_val(a, 0x7F) + key_val(b, 0x7F);
            ex[k] = (a & 0x7F) * 128 + (b & 0x7F);
        }
        float mx = val[0];
#pragma unroll
        for (int k = 1; k < 16; ++k) mx = fmaxf(mx, val[k]);
        float sum = 0.f;
#pragma unroll
        for (int k = 0; k < 16; ++k) { val[k] = expf(val[k] - mx); sum += val[k]; }
        const float inv = 1.f / sum;
#pragma unroll
        for (int k = 0; k < 16; k += 4) {
            *(int4*)(ed + k) = int4{ex[k], ex[k + 1], ex[k + 2], ex[k + 3]};
            *(float4*)(gd + k) = float4{val[k] * inv, val[k + 1] * inv, val[k + 2] * inv, val[k + 3] * inv};
        }
}

DEVI void phase8a(const Params& p, unsigned char* smem) {
    unsigned char* ws = p.ws;
    pg8::Gemm g{(const bf16_t*)(ws + WS_BUFB), (const bf16_t*)(ws + WS_WTQ), NT, 2048, D, D};
    pg8::StaticOrder S; S.init(NT, 2048, (int)gridDim.x, (int)blockIdx.x);
    EpiQ E{(bf16_t*)(ws + WS_Q)};
    pg8::gemm_phase((LAS unsigned char*)smem, g, S, E);
}

DEVI void phase8(const Params& p, unsigned char* smem_all) {
    unsigned char* smem = smem_all + VHALF * SMEM_HALF;
    unsigned char* ws = p.ws;
    const int tid = TID, lane = tid & 63, w = tid >> 6, wr = w >> 1, wc = w & 1, fr = lane & 15, fq = lane >> 4;
    const bf16_t* Q = (const bf16_t*)(ws + WS_Q);
    for (int it0 = blockIdx.x * 2; it0 < 132 * 16; it0 += NVB) {
        const int item = it0 + VHALF;
        const int mt = item >> 4, hp = item & 15;
        f32x4 acc[4][4];
        bf16_t* Qs = (bf16_t*)smem;
        bf16_t* Kb = (bf16_t*)(smem + 128 * LDW * 2);
#pragma unroll
        for (int i = 0; i < 8; ++i) {
            const int ch = tid + i * 256, r = ch >> 4, kc = ch & 15;
            *(uint4*)&Qs[r * LDW + kc * 8] = *(const uint4*)(Q + (size_t)(mt * 128 + r) * 2048 + hp * 128 + kc * 8);
            *(uint4*)&Kb[r * LDW + kc * 8] = *(const uint4*)((const bf16_t*)(ws + WS_KEYS) + hp * 16384 + r * 128 + kc * 8);
        }
        __syncthreads();
        mma_lds128(Qs, Kb, acc);
        __syncthreads();
        float* Sc = (float*)smem;
#pragma unroll
        for (int m = 0; m < 4; ++m)
#pragma unroll
            for (int n = 0; n < 4; ++n) {
                float* d = &Sc[(wr * 64 + m * 16 + fr) * 130 + wc * 64 + n * 16 + fq * 4];
                d[0] = acc[m][n][0]; d[1] = acc[m][n][1]; d[2] = acc[m][n][2]; d[3] = acc[m][n][3];
            }
        __syncthreads();
        {
            const int row = tid >> 1, half = tid & 1;
            const float* sr = &Sc[row * 130 + half];
            int R[16];
#pragma unroll
            for (int g = 0; g < 4; ++g) {
                int Nn[16];
#pragma unroll
                for (int i = 0; i < 16; ++i) { const int idx = 2 * (g * 16 + i) + half; Nn[i] = key_enc(sr[2 * (g * 16 + i)], idx, 0x7F); }
                bitonic_sort_desc<16>(Nn);
                if (g == 0) {
#pragma unroll
                    for (int i = 0; i < 16; ++i) R[i] = Nn[i];
                } else {
#pragma unroll
                    for (int i = 0; i < 16; ++i) R[i] = max(R[i], Nn[15 - i]);
                    bitonic_merge16_desc(R);
                }
            }
            int T[16];
#pragma unroll
            for (int i = 0; i < 16; ++i) T[i] = __shfl_xor(R[15 - i], 1);
#pragma unroll
            for (int i = 0; i < 16; ++i) R[i] = max(R[i], T[i]);
            bitonic_merge16_desc(R);
            __syncthreads();
            if (half == 0) {
                int* dst = (int*)smem + row * 16;
                *(int4*)dst = int4{R[0], R[1], R[2], R[3]}; *(int4*)(dst + 4) = int4{R[4], R[5], R[6], R[7]};
                *(int4*)(dst + 8) = int4{R[8], R[9], R[10], R[11]}; *(int4*)(dst + 12) = int4{R[12], R[13], R[14], R[15]};
            }
        }
        __syncthreads();
        if (threadIdx.x < 128) {
            const int tok = mt * 128 + (int)threadIdx.x, hh = hp >> 1;
            combine_pair((const int*)smem_all + threadIdx.x * 16, (const int*)(smem_all + SMEM_HALF) + threadIdx.x * 16,
                         (int*)(ws + WS_EG) + (size_t)tok * 128 + hh * 16, (float*)(ws + WS_GG) + (size_t)tok * 128 + hh * 16);
        }
        __syncthreads();
    }
}

DEVI float dpp_sum_to_lane63(float v) {
    v += __builtin_bit_cast(float, __builtin_amdgcn_update_dpp(0, __builtin_bit_cast(int, v), 0x111, 0xf, 0xf, true));
    v += __builtin_bit_cast(float, __builtin_amdgcn_update_dpp(0, __builtin_bit_cast(int, v), 0x112, 0xf, 0xf, true));
    v += __builtin_bit_cast(float, __builtin_amdgcn_update_dpp(0, __builtin_bit_cast(int, v), 0x114, 0xf, 0xf, true));
    v += __builtin_bit_cast(float, __builtin_amdgcn_update_dpp(0, __builtin_bit_cast(int, v), 0x118, 0xf, 0xf, true));
    v += __builtin_bit_cast(float, __builtin_amdgcn_update_dpp(0, __builtin_bit_cast(int, v), 0x142, 0xa, 0xf, false));
    v += __builtin_bit_cast(float, __builtin_amdgcn_update_dpp(0, __builtin_bit_cast(int, v), 0x143, 0xc, 0xf, false));
    return v;
}
DEVI float dpp_sum_half(float v) {
    v += __builtin_bit_cast(float, __builtin_amdgcn_update_dpp(0, __builtin_bit_cast(int, v), 0x111, 0xf, 0xf, true));
    v += __builtin_bit_cast(float, __builtin_amdgcn_update_dpp(0, __builtin_bit_cast(int, v), 0x112, 0xf, 0xf, true));
    v += __builtin_bit_cast(float, __builtin_amdgcn_update_dpp(0, __builtin_bit_cast(int, v), 0x114, 0xf, 0xf, true));
    v += __builtin_bit_cast(float, __builtin_amdgcn_update_dpp(0, __builtin_bit_cast(int, v), 0x118, 0xf, 0xf, true));
    v += __builtin_bit_cast(float, __builtin_amdgcn_update_dpp(0, __builtin_bit_cast(int, v), 0x142, 0xa, 0xf, false));
    return v;
}
DEVI float rdlane(float v, int l) { return __builtin_bit_cast(float, __builtin_amdgcn_readlane(__builtin_bit_cast(int, v), l)); }
DEVI int rdlanei(int v, int l) { return __builtin_amdgcn_readlane(v, l); }

DEVI void phase10(const Params& p, unsigned char* smem) {
    (void)smem;
    unsigned char* ws = p.ws;
    const int tid = threadIdx.x, lane = tid & 63, w = tid >> 6;
    const unsigned char* UT = ws + WS_UT;
    const unsigned char* VT = ws + WS_VT;
    const float* USC = (const float*)(ws + WS_USC);
    const float* VSC = (const float*)(ws + WS_VSC);
    const bf16_t* u2 = (const bf16_t*)(ws + WS_BUFB);
    const float* mod = (const float*)(ws + WS_MOD);
    unsigned* cnt = (unsigned*)(ws + WS_CTL) + CW_CNT;
    for (;;) {
        int tok = 0;
        if (lane == 0) tok = (int)atomicAdd(cnt, 1u);
        tok = __builtin_amdgcn_readfirstlane(tok);
        if (tok >= NT) break;
        const int* Eg = (const int*)(ws + WS_EG) + (size_t)tok * 128;
        const float* Gg = (const float*)(ws + WS_GG) + (size_t)tok * 128;
        const int ea = Eg[lane], eb = Eg[lane + 64];
        const float ga = Gg[lane], gb = Gg[lane + 64];
        const float sua = USC[ea], sub = USC[eb], sva = VSC[ea], svb = VSC[eb];
        const int hl = lane & 31, hi = lane >> 5;
        f32x2 uf[16];
        {
            const bf16_t* ur = u2 + (size_t)tok * D + hl * 32;
#pragma unroll
            for (int q = 0; q < 4; ++q) {
                const uint4 qv = *(const uint4*)(ur + q * 8);
                uf[q * 4 + 0] = f32x2{bf_lo(qv.x), bf_hi(qv.x)}; uf[q * 4 + 1] = f32x2{bf_lo(qv.y), bf_hi(qv.y)};
                uf[q * 4 + 2] = f32x2{bf_lo(qv.z), bf_hi(qv.z)}; uf[q * 4 + 3] = f32x2{bf_lo(qv.w), bf_hi(qv.w)};
            }
        }
        float act_a = 0.f, act_b = 0.f;
#pragma unroll
        for (int hb = 0; hb < 2; ++hb) {
            const int esel = hb ? eb : ea;
            float actv = 0.f;
            for (int jb = 0; jb < 64; jb += 32) {
                u32x4 x[16];
#pragma unroll
                for (int i = 0; i < 16; ++i) {
                    const int eA = rdlanei(esel, jb + i), eB = rdlanei(esel, jb + 16 + i);
                    const int e = hi ? eB : eA;
                    x[i] = *(const u32x4*)(UT + (size_t)e * 512 + hl * 16);
                }
#pragma unroll
                for (int i = 0; i < 16; ++i) {
                    f32x2 a2 = f32x2{0.f, 0.f};
#pragma unroll
                    for (int wq = 0; wq < 4; ++wq) {
                        a2 += __builtin_amdgcn_cvt_scalef32_pk_f32_fp4(x[i][wq], 1.0f, 0) * uf[wq * 4 + 0];
                        a2 += __builtin_amdgcn_cvt_scalef32_pk_f32_fp4(x[i][wq], 1.0f, 1) * uf[wq * 4 + 1];
                        a2 += __builtin_amdgcn_cvt_scalef32_pk_f32_fp4(x[i][wq], 1.0f, 2) * uf[wq * 4 + 2];
                        a2 += __builtin_amdgcn_cvt_scalef32_pk_f32_fp4(x[i][wq], 1.0f, 3) * uf[wq * 4 + 3];
                    }
                    const float hs = dpp_sum_half(a2.x + a2.y);
                    const float totA = rdlane(hs, 31), totB = rdlane(hs, 63);
                    actv = (lane == jb + i) ? totA : actv;
                    actv = (lane == jb + 16 + i) ? totB : actv;
                }
            }
            if (hb) act_b = actv; else act_a = actv;
        }
        const float cfa = ga * gelu_exact(act_a * sua) * sva;
        const float cfb = gb * gelu_exact(act_b * sub) * svb;
        f32x2 ya[16];
#pragma unroll
        for (int i = 0; i < 16; ++i) ya[i] = f32x2{0.f, 0.f};
#pragma unroll
        for (int hb = 0; hb < 2; ++hb) {
            const int esel = hb ? eb : ea;
            const float csel = hb ? cfb : cfa;
            for (int jb = 0; jb < 64; jb += 32) {
                u32x4 x[16];
#pragma unroll
                for (int i = 0; i < 16; ++i) {
                    const int eA = rdlanei(esel, jb + i), eB = rdlanei(esel, jb + 16 + i);
                    const int e = hi ? eB : eA;
                    x[i] = *(const u32x4*)(VT + (size_t)e * 512 + hl * 16);
                }
#pragma unroll
                for (int i = 0; i < 16; ++i) {
                    const float cA = rdlane(csel, jb + i), cB = rdlane(csel, jb + 16 + i);
                    const float cf = hi ? cB : cA;
                    const f32x2 c2 = f32x2{cf, cf};
#pragma unroll
                    for (int wq = 0; wq < 4; ++wq) {
                        ya[wq * 4 + 0] += c2 * __builtin_amdgcn_cvt_scalef32_pk_f32_fp4(x[i][wq], 1.0f, 0);
                        ya[wq * 4 + 1] += c2 * __builtin_amdgcn_cvt_scalef32_pk_f32_fp4(x[i][wq], 1.0f, 1);
                        ya[wq * 4 + 2] += c2 * __builtin_amdgcn_cvt_scalef32_pk_f32_fp4(x[i][wq], 1.0f, 2);
                        ya[wq * 4 + 3] += c2 * __builtin_amdgcn_cvt_scalef32_pk_f32_fp4(x[i][wq], 1.0f, 3);
                    }
                }
            }
        }
#pragma unroll
        for (int i = 0; i < 16; ++i) { ya[i].x += __shfl_xor(ya[i].x, 32); ya[i].y += __shfl_xor(ya[i].y, 32); }
        const int cbase = hl * 32 + hi * 16;
        float* xo = p.out + (size_t)tok * D + cbase;
        const float* g2 = mod + (size_t)seq_of(tok) * NMOD + 5120 + cbase;
        float r[16];
        float s1 = 0.f;
#pragma unroll
        for (int i = 0; i < 4; ++i) {
            const float4 xv = *(const float4*)(xo + i * 4), gv = *(const float4*)(g2 + i * 4);
            const f32x2 y0 = hi ? ya[8 + i * 2] : ya[i * 2], y1 = hi ? ya[8 + i * 2 + 1] : ya[i * 2 + 1];
            r[i * 4 + 0] = ALPHA * xv.x + (1.f + gv.x) * y0.x; r[i * 4 + 1] = ALPHA * xv.y + (1.f + gv.y) * y0.y;
            r[i * 4 + 2] = ALPHA * xv.z + (1.f + gv.z) * y1.x; r[i * 4 + 3] = ALPHA * xv.w + (1.f + gv.w) * y1.y;
            s1 += r[i * 4] + r[i * 4 + 1] + r[i * 4 + 2] + r[i * 4 + 3];
        }
        const float mean = wave_sum(s1) * (1.f / 1024.f);
        float s2 = 0.f;
#pragma unroll
        for (int i = 0; i < 16; ++i) { r[i] -= mean; s2 += r[i] * r[i]; }
        const float rstd = rsqrtf(wave_sum(s2) * (1.f / 1024.f) + LN_EPS);
#pragma unroll
        for (int i = 0; i < 4; ++i) {
            const float4 la = *(const float4*)(p.ln2_g + cbase + i * 4), ba = *(const float4*)(p.ln2_b + cbase + i * 4);
            *(float4*)(xo + i * 4) = float4{r[i * 4] * rstd * la.x + ba.x, r[i * 4 + 1] * rstd * la.y + ba.y, r[i * 4 + 2] * rstd * la.z + ba.z, r[i * 4 + 3] * rstd * la.w + ba.w};
        }
    }
}

__global__ void __launch_bounds__(512, 2) mk_fwd(Params p, int ph_lo, int ph_hi, int use_cg) {
    extern __shared__ __attribute__((aligned(16))) unsigned char smem[];
    volatile LAS unsigned* xbw = (volatile LAS unsigned*)((LAS unsigned char*)smem + SMEM_BYTES);
    XcdBarrier bar; bar.bar = (unsigned*)(p.ws + WS_CTL) + CW_BAR; bar.x = 0; bar.st = xbw;
    if (ph_hi - ph_lo > 1 && !use_cg) {
        if (threadIdx.x < 4) xbw[threadIdx.x] = 0u;
        __syncthreads();
        bar = xcd_barrier_post((unsigned*)(p.ws + WS_CTL) + CW_BAR, xbw);
    }
#define SEAM(k) do { if (ph_lo <= (k) && (k) + 1 < ph_hi) { if (use_cg) cg::this_grid().sync(); else xcd_barrier(bar); } } while (0)
#define RUN(k) (ph_lo <= (k) && (k) < ph_hi)
    if (RUN(0)) phase0(p, smem);
    SEAM(0);
    if (RUN(1)) phase1(p, smem);
    SEAM(1);
    if (RUN(2)) phase2(p, smem);
    SEAM(2);
#ifndef REPA
#define REPA 1
#endif
#ifndef REPB
#define REPB 1
#endif
#ifndef REPC
#define REPC 1
#endif
#ifndef REPD
#define REPD 1
#endif
    if (RUN(3)) for (int r = 0; r < REPA; ++r) { phase3(p, smem); if (r + 1 < REPA) xcd_barrier(bar); }
    SEAM(3);
    if (RUN(4)) for (int r = 0; r < REPB; ++r) { phase4(p, smem); if (r + 1 < REPB) xcd_barrier(bar); }
    SEAM(4);
    if (RUN(5)) phase5(p, smem);
    SEAM(5);
    if (RUN(6)) phase6(p, smem);
    SEAM(6);
    if (RUN(7)) phase7(p);
    SEAM(7);
    if (RUN(8)) for (int r = 0; r < REPC; ++r) { phase8a(p, smem); if (r + 1 < REPC) xcd_barrier(bar); }
    SEAM(8);
    if (RUN(9)) for (int r = 0; r < REPD; ++r) { phase8(p, smem); if (r + 1 < REPD) xcd_barrier(bar); }
    SEAM(9);
    if (RUN(10)) phase10(p, smem);
}

extern "C" void kernel_launch(void* const* d_in, const int* in_sizes, int n_in, void* d_out, int out_size, void* d_ws, size_t ws_size, hipStream_t stream) {
    static int grid = 0;
    if (grid == 0) {
        int dev = 0, cus = 0, per_cu = 0;
        (void)hipGetDevice(&dev);
        (void)hipDeviceGetAttribute(&cus, hipDeviceAttributeMultiprocessorCount, dev);
        (void)hipFuncSetAttribute((const void*)mk_fwd, hipFuncAttributeMaxDynamicSharedMemorySize, LDS_DYN);
        (void)hipOccupancyMaxActiveBlocksPerMultiprocessor(&per_cu, (const void*)mk_fwd, 512, LDS_DYN);
        if (per_cu < 1) fprintf(stderr, "kernel_launch: occupancy query says %d workgroups per CU\n", per_cu);
        grid = cus;
        if (ws_size < WS_END) fprintf(stderr, "kernel_launch: workspace too small: %zu < %zu\n", ws_size, (size_t)WS_END);
    }
    Params p{};
    const float** f = (const float**)&p;
    for (int i = 0; i < 24; ++i) f[i] = (const float*)d_in[i];
    p.out = (float*)d_out; p.ws = (unsigned char*)d_ws;
    (void)hipMemsetAsync((unsigned char*)d_ws + WS_CTL, 0, 65536, stream);
    int lo = 0, hi = NPH, ucg = 0;
    void* args[] = {&p, &lo, &hi, &ucg};
    hipError_t e = hipLaunchCooperativeKernel((const void*)mk_fwd, dim3(grid), dim3(512), args, LDS_DYN, stream);
    if (e != hipSuccess) fprintf(stderr, "cooperative launch failed: %s (grid %d)\n", hipGetErrorString(e), grid);
}
#ifdef TEST4
__global__ void __launch_bounds__(512, 2) t4(Params p) { extern __shared__ __attribute__((aligned(16))) unsigned char sm4[]; phase4(p, sm4); }
__global__ void __launch_bounds__(512, 2) t4s(Params p) { extern __shared__ __attribute__((aligned(16))) unsigned char sm4[]; p4_state_scan(p, sm4 + VHALF * SMEM_HALF, blockIdx.x * 2 + VHALF); }
__global__ void __launch_bounds__(512, 2) t3(Params p) { extern __shared__ __attribute__((aligned(16))) unsigned char sm4[]; phase3(p, sm4); }
__global__ void __launch_bounds__(512, 2) t6(Params p) { extern __shared__ __attribute__((aligned(16))) unsigned char sm4[]; phase6(p, sm4); }
#endif
```

```cpp
#include <hip/hip_runtime.h>
#include <hip/hip_cooperative_groups.h>
#include <cstdio>
#include <cstdint>
namespace cg = cooperative_groups;


#ifndef UFP4
#define UFP4 1
#endif
#ifndef FUSED
#define FUSED 1
#endif

#define DEVI __device__ __forceinline__
#define TID ((int)(threadIdx.x & 255u))
#define VHALF ((int)(threadIdx.x >> 8))
#define NVB ((int)gridDim.x * 2)
#define LAS __attribute__((address_space(3)))

typedef unsigned short bf16_t;
typedef short bf16x8 __attribute__((ext_vector_type(8)));
typedef short s16x4 __attribute__((ext_vector_type(4)));
typedef float f32x4 __attribute__((ext_vector_type(4)));
typedef unsigned u32x4 __attribute__((ext_vector_type(4)));
typedef __bf16 bf2_t __attribute__((ext_vector_type(2)));

constexpr int D = 1024, NTP = 16384, NTS = 512, NT = NTP + NTS, SEQ = 2048, NSEQ = 136;
constexpr int DIN = 2568, NP = 2560, NMOD = 6144;
constexpr int NPH = 11;
constexpr float ALPHA = 1.189207115002721f;
constexpr float LN_EPS = 1e-5f;
constexpr float KSCALE = 0.08838834764831845f;

constexpr size_t O_Y = 0, O_POOLP = 17301504, O_CP = 17362944, O_NP = 17887232, O_MP = 17891328,
                 O_POOLS = 17891360, O_CS = 18874400, O_NS = 27263008, O_MS = 27328544;

constexpr size_t WS_CTL = 0;
constexpr size_t WS_MOD = 65536;
constexpr size_t WS_GATES = WS_MOD + 6291456;
constexpr size_t WS_MST = WS_GATES + 540672;
constexpr size_t WS_NST = WS_MST + 8192;
constexpr size_t WS_WTIN = WS_NST + 524288;
constexpr size_t WS_WTOUT = WS_WTIN + 5242880;
constexpr size_t WS_WTQ = WS_WTOUT + 2097152;
constexpr size_t WS_WTMOD = WS_WTQ + 4194304;
constexpr size_t WS_GA = WS_WTMOD;
constexpr size_t WS_BB = WS_GA + 262144;
constexpr size_t WS_RR = WS_BB + 262144;
constexpr size_t WS_RPM = WS_RR + 262144;
constexpr size_t WS_BCH = WS_RPM + 262144;
constexpr size_t WS_WTPOOL = WS_WTMOD + 12582912;
constexpr size_t WS_KEYS = WS_WTPOOL + 131072;
constexpr size_t WS_AMOD = WS_KEYS + 524288;
constexpr size_t WS_UT = WS_AMOD + 524288;
constexpr size_t WS_USC = WS_UT + 16777216;
constexpr size_t WS_VT = WS_UT + 33554432;
constexpr size_t WS_VSC = WS_VT + 16777216;
constexpr size_t WS_BUFA = WS_VT + 33554432;
constexpr size_t WS_BUFB = WS_BUFA + 34603008;
constexpr size_t WS_P = WS_BUFB + 34603008;
constexpr size_t WS_PART = WS_P;
constexpr size_t WS_Q = WS_P;
constexpr size_t WS_K16 = WS_P + 69206016;
constexpr size_t WS_EG = WS_BUFA;
constexpr size_t WS_GG = WS_EG + 8650752;
constexpr size_t WS_END = WS_P + 86507520;

constexpr int CW_BAR = 0;
constexpr int CW_CNT = 4096;

struct Params {
    const float *x_prompt, *x_sample, *c_prompt, *c_sample, *state_pool, *state_C, *state_n, *state_m;
    const float *w_mod, *b_mod, *w_in, *b_in, *w_pool, *pool_scale, *mh_norm_g, *w_out, *ln1_g, *ln1_b;
    const float *w_q, *sub_keys, *u_tab, *v_tab, *ln2_g, *ln2_b;
    float* out;
    unsigned char* ws;
};

typedef float f32x2 __attribute__((ext_vector_type(2)));
DEVI unsigned pack2(float lo, float hi) { const f32x2 v = {lo, hi}; const bf2_t b = __builtin_convertvector(v, bf2_t); return __builtin_bit_cast(unsigned, b); }
DEVI float dot2bf(unsigned a, unsigned b, float c) { return __builtin_amdgcn_fdot2_f32_bf16(__builtin_bit_cast(bf2_t, a), __builtin_bit_cast(bf2_t, b), c, false); }
DEVI float bf_lo(unsigned u) { return __uint_as_float(u << 16); }
DEVI float bf_hi(unsigned u) { return __uint_as_float(u & 0xFFFF0000u); }
DEVI float bf1(bf16_t h) { return __uint_as_float(((unsigned)h) << 16); }
DEVI float wave_sum(float v) {
#pragma unroll
    for (int o = 32; o > 0; o >>= 1) v += __shfl_xor(v, o);
    return v;
}
DEVI float sum16(float v) {
#pragma unroll
    for (int o = 8; o > 0; o >>= 1) v += __shfl_xor(v, o);
    return v;
}
DEVI float sumq(float v) {
    v += __shfl_xor(v, 16); v += __shfl_xor(v, 32); return v;
}
DEVI float logsigmoid(float x) { return fminf(x, 0.f) - log1pf(expf(-fabsf(x))); }
DEVI float sigmoidf_(float x) { return 1.f / (1.f + expf(-x)); }
DEVI float gelu_exact(float x) { return 0.5f * x * (1.f + erff(x * 0.7071067811865476f)); }
DEVI float scan_sum_incl(float v, int lane) {
#pragma unroll
    for (int o = 1; o < 64; o <<= 1) { float t = __shfl_up(v, o); if (lane >= o) v += t; }
    return v;
}
DEVI float scan_max_incl(float v, int lane) {
#pragma unroll
    for (int o = 1; o < 64; o <<= 1) { float t = __shfl_up(v, o); if (lane >= o) v = fmaxf(v, t); }
    return v;
}
DEVI const float* xrow_ptr(const Params& p, int tok) { return tok < NTP ? p.x_prompt + (size_t)tok * D : p.x_sample + (size_t)(tok - NTP) * D; }
DEVI int seq_of(int tok) { return tok < NTP ? (tok >> 11) : 8 + ((tok - NTP) >> 2); }

DEVI int key_enc(float f, int payload, int mask) { int b = __float_as_int(f); int k = b ^ ((b >> 31) & 0x7FFFFFFF); return (k & ~mask) | payload; }
DEVI float key_val(int k, int mask) { int k2 = k & ~mask; return __int_as_float(k2 ^ ((k2 >> 31) & 0x7FFFFFFF)); }

template <int N> DEVI void bitonic_sort_desc(int (&a)[N]) {
#pragma unroll
    for (int k = 2; k <= N; k <<= 1) {
#pragma unroll
        for (int j = k >> 1; j > 0; j >>= 1) {
#pragma unroll
            for (int i = 0; i < N; ++i) {
                const int l = i ^ j;
                if (l > i) {
                    const bool desc = ((i & k) == 0);
                    const int mx = max(a[i], a[l]), mn = min(a[i], a[l]);
                    a[i] = desc ? mx : mn; a[l] = desc ? mn : mx;
                }
            }
        }
    }
}
DEVI void bitonic_merge16_desc(int (&a)[16]) {
#pragma unroll
    for (int j = 8; j > 0; j >>= 1) {
#pragma unroll
        for (int i = 0; i < 16; ++i) {
            const int l = i ^ j;
            if (l > i) { const int mx = max(a[i], a[l]), mn = min(a[i], a[l]); a[i] = mx; a[l] = mn; }
        }
    }
}

#define XB_TMO      128
#define XB_XCNT(j)  (256  + 64 * (j))
#define XB_XSUB(j)  (1280 + 64 * (j))
#define XB_XGEN(j)  (2304 + 64 * (j))
#define XB_TOP      3328
#define XB_TOPGEN   3392
#define XCD_BAR_WORDS 3456
#define XB_SPIN_CAP (1u << 22)
DEVI unsigned xb_ld(unsigned* p) { return __hip_atomic_load(p, __ATOMIC_RELAXED, __HIP_MEMORY_SCOPE_AGENT); }
DEVI unsigned xb_add(unsigned* p, unsigned v) { return __hip_atomic_fetch_add(p, v, __ATOMIC_RELAXED, __HIP_MEMORY_SCOPE_AGENT); }
DEVI unsigned xb_xcc_id() { return (unsigned)__builtin_amdgcn_s_getreg((3 << 11) | 20) & 0xFu; }
#define XB_SPIN(cond, bar) do { unsigned _sp = 0; while (cond) { __builtin_amdgcn_s_sleep(1); \
    if ((++_sp & 255u) == 0u) { if (xb_ld(&(bar)[XB_TMO])) break; if (_sp > XB_SPIN_CAP) { atomicAdd(&(bar)[XB_TMO], 1u); break; } } } } while (0)
struct XcdBarrier { unsigned* bar; unsigned x; volatile LAS unsigned* st; };
DEVI XcdBarrier xcd_barrier_post(unsigned* bar, volatile LAS unsigned* st) {
    XcdBarrier b; b.bar = bar; b.x = xb_xcc_id(); b.st = st;
    if (threadIdx.x == 0) (void)xb_add(&bar[XB_XCNT(b.x)], 1u);
    return b;
}
DEVI void xcd_barrier_complete(unsigned* bar, unsigned x, unsigned& nloc, unsigned& nx) {
    const unsigned G = gridDim.x * gridDim.y * gridDim.z;
    unsigned sum, cnt, mine, sp = 0u;
    for (;;) {
        sum = 0u; cnt = 0u; mine = 0u;
#pragma unroll
        for (unsigned j = 0; j < 16; ++j) { const unsigned c = xb_ld(&bar[XB_XCNT(j)]); sum += c; cnt += (c > 0u) ? 1u : 0u; mine = (j == x) ? c : mine; }
        if (sum == G) break;
        __builtin_amdgcn_s_sleep(1);
        if ((++sp & 255u) == 0u) { if (xb_ld(&bar[XB_TMO])) break; if (sp > XB_SPIN_CAP) { atomicAdd(&bar[XB_TMO], 1u); break; } }
    }
    nloc = mine > 0u ? mine : 1u; nx = cnt > 0u ? cnt : 1u;
}
DEVI void xcd_barrier(const XcdBarrier& b) {
    asm volatile("s_waitcnt vmcnt(0)" ::: "memory");
    __syncthreads();
    if (threadIdx.x == 0) {
        unsigned* bar = b.bar;
        __builtin_amdgcn_s_waitcnt(0);
        unsigned nloc = b.st[0], nx = b.st[1];
        if (nloc == 0u) { xcd_barrier_complete(bar, b.x, nloc, nx); b.st[0] = nloc; b.st[1] = nx; }
        const unsigned old = xb_add(&bar[XB_XSUB(b.x)], 1u);
        const unsigned gen = old / nloc;
        if (old + 1u == (gen + 1u) * nloc) {
            __builtin_amdgcn_fence(__ATOMIC_RELEASE, "agent");
            asm volatile("s_waitcnt vmcnt(0)" ::: "memory");
            const unsigned og = xb_add(&bar[XB_TOP], 1u);
            const unsigned tg = og / nx;
            if (og + 1u == (tg + 1u) * nx) xb_add(&bar[XB_TOPGEN], 1u);
            else XB_SPIN(xb_ld(&bar[XB_TOPGEN]) == tg, bar);
            __builtin_amdgcn_fence(__ATOMIC_ACQUIRE, "agent");
            xb_add(&bar[XB_XGEN(b.x)], 1u);
            asm volatile("s_waitcnt vmcnt(0)" ::: "memory");
        } else {
            XB_SPIN(xb_ld(&bar[XB_XGEN(b.x)]) == gen, bar);
            __builtin_amdgcn_fence(__ATOMIC_ACQUIRE, "agent");
            asm volatile("s_waitcnt vmcnt(0)" ::: "memory");
        }
    }
    __syncthreads();
}

constexpr int SMEM_HALF = 73728;
constexpr int SMEM_BYTES = 2 * SMEM_HALF;
constexpr int LDS_DYN = SMEM_BYTES + 64;
constexpr int LDT = 72;
constexpr int LDW = 136;

DEVI void mma_lds128(const bf16_t* Al, const bf16_t* Bl, f32x4 (&acc)[4][4]) {
    const int tid = TID, lane = tid & 63, w = tid >> 6, wr = w >> 1, wc = w & 1, fr = lane & 15, fq = lane >> 4;
#pragma unroll
    for (int m = 0; m < 4; ++m)
#pragma unroll
        for (int n = 0; n < 4; ++n) acc[m][n] = f32x4{0.f, 0.f, 0.f, 0.f};
#pragma unroll
    for (int ks = 0; ks < 4; ++ks) {
        bf16x8 a[4], b[4];
#pragma unroll
        for (int m = 0; m < 4; ++m) a[m] = *(const bf16x8*)&Al[(wr * 64 + m * 16 + fr) * LDW + ks * 32 + fq * 8];
#pragma unroll
        for (int n = 0; n < 4; ++n) b[n] = *(const bf16x8*)&Bl[(wc * 64 + n * 16 + fr) * LDW + ks * 32 + fq * 8];
#pragma unroll
        for (int m = 0; m < 4; ++m)
#pragma unroll
            for (int n = 0; n < 4; ++n) acc[m][n] = __builtin_amdgcn_mfma_f32_16x16x32_bf16(b[n], a[m], acc[m][n], 0, 0, 0);
    }
}

DEVI bf16x8 tr_frag(const bf16_t* base, int ld, int row0, int col0, int lane) {
    const int g = lane >> 4, li = lane & 15, q = li >> 2, pp = li & 3;
    const bf16_t* a0 = base + (row0 + g * 8 + q) * ld + col0 + pp * 4;
    s16x4 lo = __builtin_amdgcn_ds_read_tr16_b64_v4i16((LAS s16x4*)a0);
    s16x4 hi = __builtin_amdgcn_ds_read_tr16_b64_v4i16((LAS s16x4*)(a0 + 4 * ld));
    return bf16x8{lo[0], lo[1], lo[2], lo[3], hi[0], hi[1], hi[2], hi[3]};
}


namespace pg8 {
constexpr int BM = 256, BK = 64, HALF = 128, HTB = HALF * BK * 2, STAGE_BYTES = 8 * HTB, NXCD = 8, WGM = 8;
__host__ __device__ __forceinline__ int lds_byte(int r, int c) { const int st = (r >> 4) * 2 + (c >> 5), rr = r & 15, cc = c & 31, ob = rr * 64 + cc * 2; return st * 1024 + (ob ^ (((ob >> 9) & 1) << 5)); }
__host__ __device__ __forceinline__ void stage_rc(int b, int& R, int& C) { const int st = b / 1024, sb = b % 1024, swz = sb ^ (((sb >> 9) & 1) << 5); R = (st >> 1) * 16 + swz / 64; C = (st & 1) * 32 + (swz % 64) / 2; }
__host__ __device__ __forceinline__ int perm32(int rho) { const int n = rho >> 4, i = rho & 15; return 8 * (i >> 2) + 4 * n + (i & 3); }
struct Unit { int pm, pn; };
struct Gemm { const bf16_t* A; const bf16_t* Bt; int M, N, K, ld; };
struct StaticOrder {
    int nM, nN, nwg, G, c;
    __device__ void init(int M, int N, int G_, int c_) { nM = M / BM; nN = N / BM; nwg = nM * nN; G = G_; c = c_; }
    __device__ bool next(int i, Unit& u) const {
        const long L = (long)i * G + c; if (L >= nwg) return false;
        int wgid = (int)L; { const int q = nwg / NXCD, r = nwg % NXCD, xcd = wgid % NXCD, off = wgid / NXCD; wgid = (xcd < r ? xcd * (q + 1) : r * (q + 1) + (xcd - r) * q) + off; }
        const int nig = WGM * nN, gid = wgid / nig, fm = gid * WGM, gsz = (nM - fm) < WGM ? (nM - fm) : WGM;
        u.pm = fm + ((wgid % nig) % gsz); u.pn = (wgid % nig) / gsz; return true;
    }
};
struct OneUnit {
    bool has; Unit u;
    __device__ bool next(int i, Unit& o) const { if (i != 0 || !has) return false; o = u; return true; }
};
template <class Epi, class Order>
__device__ __forceinline__ void gemm_phase(LAS unsigned char* lds, const Gemm g, const Order& S, const Epi& E) {
    const int tid = threadIdx.x, wid = __builtin_amdgcn_readfirstlane(tid >> 6), lane = tid & 63, wr = wid >> 2, wc = wid & 3, fr = lane & 15, fq = lane >> 4;
    const int K = g.K, nt = K / BK, LD = g.ld;
    unsigned voffA[2], voffB[2];
#pragma unroll
    for (int i = 0; i < 2; ++i) { int R, C; stage_rc(tid * 16 + i * 8192, R, C); const int Rb = (R & ~31) + perm32(R & 31);
        voffA[i] = (unsigned)(R * LD + C) * 2u; voffB[i] = (unsigned)(Rb * LD + C) * 2u; }
    const size_t kstep = (size_t)(BK * 2);
    const size_t hstep = (size_t)HALF * LD * 2;
    const size_t tstep = 2 * hstep;
    const unsigned ldsw = (unsigned)wid * 1024u;
    const int aoff = lds_byte(wr * 64 + fr, fq * 8), boff = lds_byte(wc * 32 + fr, fq * 8);
#define PG8_SA(b, h) (((b) * 2 + (h)) * HTB)
#define PG8_SB(b, h) ((4 + (b) * 2 + (h)) * HTB)
#define PG8_STAGE(bufoff, gbase, voff) do { _Pragma("unroll") for (int _i = 0; _i < 2; ++_i) \
        __builtin_amdgcn_global_load_lds((const unsigned*)((const char*)(gbase) + (voff)[_i]), (LAS unsigned*)(lds + (bufoff) + ldsw + _i * 8192), 16, 0, 0); } while (0)
#define PG8_LDA(dst, b, h) do { _Pragma("unroll") for (int m = 0; m < 4; ++m) _Pragma("unroll") for (int k = 0; k < 2; ++k) dst[m][k] = *(const LAS bf16x8*)(lds + PG8_SA(b, h) + aoff + m * 2048 + k * 1024); } while (0)
#define PG8_LDB(dst, b, h) do { _Pragma("unroll") for (int n = 0; n < 2; ++n) _Pragma("unroll") for (int k = 0; k < 2; ++k) dst[n][k] = *(const LAS bf16x8*)(lds + PG8_SB(b, h) + boff + n * 2048 + k * 1024); } while (0)
#define PG8_MMA(ai, bj, At, Bt) do { __builtin_amdgcn_s_setprio(1); _Pragma("unroll") for (int m = 0; m < 4; ++m) _Pragma("unroll") for (int n = 0; n < 2; ++n) _Pragma("unroll") for (int k = 0; k < 2; ++k) \
        acc[ai][bj][m][n] = __builtin_amdgcn_mfma_f32_16x16x32_bf16(Bt[n][k], At[m][k], acc[ai][bj][m][n], 0, 0, 0); __builtin_amdgcn_s_setprio(0); } while (0)
#define PG8_WAIT_V(n) asm volatile("s_waitcnt vmcnt(" #n ")" ::: "memory")
#define PG8_WAIT_L(n) asm volatile("s_waitcnt lgkmcnt(" #n ")" ::: "memory")
#define PG8_BAR __builtin_amdgcn_s_barrier()
#define PG8_SCHED __builtin_amdgcn_sched_barrier(0)
    Unit cur, nxt; int ui = 0;
    if (!S.next(0, cur)) return;
    f32x4 acc[2][2][4][2];
#pragma unroll
    for (int a = 0; a < 2; ++a)
#pragma unroll
        for (int b = 0; b < 2; ++b)
#pragma unroll
            for (int m = 0; m < 4; ++m)
#pragma unroll
                for (int n = 0; n < 2; ++n) acc[a][b][m][n] = (f32x4){0.f, 0.f, 0.f, 0.f};
    bf16x8 At[4][2], B0[2][2], B1[2][2];
    const char* cA = (const char*)g.A + (size_t)cur.pm * tstep; const char* cB = (const char*)g.Bt + (size_t)cur.pn * tstep;
    PG8_STAGE(PG8_SB(0, 0), cB, voffB); PG8_STAGE(PG8_SB(0, 1), cB + hstep, voffB); PG8_STAGE(PG8_SA(0, 0), cA, voffA); PG8_STAGE(PG8_SA(0, 1), cA + hstep, voffA);
    if (wr == 1) PG8_BAR;
    PG8_WAIT_V(2); PG8_BAR;
    PG8_STAGE(PG8_SB(1, 0), cB + kstep, voffB); PG8_STAGE(PG8_SA(1, 0), cA + kstep, voffA); PG8_STAGE(PG8_SB(1, 1), cB + hstep + kstep, voffB);
    PG8_WAIT_V(6); PG8_BAR;
    for (;;) {
        const bool has_next = S.next(ui + 1, nxt);
        const char* nA = has_next ? (const char*)g.A + (size_t)nxt.pm * tstep : cA; const char* nB = has_next ? (const char*)g.Bt + (size_t)nxt.pn * tstep : cB;
        for (int t = 0; t < nt; t += 2) {
            const bool last = (t == nt - 2);
            const char* a1 = cA + (size_t)(t + 1) * kstep;
            const char* a2 = last ? nA : cA + (size_t)(t + 2) * kstep; const char* b2 = last ? nB : cB + (size_t)(t + 2) * kstep;
            const char* a3 = a2 + kstep; const char* b3 = b2 + kstep;
            PG8_LDB(B0, 0, 0); PG8_LDB(B1, 0, 1); PG8_SCHED; PG8_LDA(At, 0, 0); PG8_STAGE(PG8_SA(1, 1), a1 + hstep, voffA);
            PG8_WAIT_V(8); PG8_WAIT_L(0); PG8_BAR; PG8_MMA(0, 0, At, B0); PG8_MMA(0, 1, At, B1); PG8_BAR; PG8_SCHED;
            PG8_LDA(At, 0, 1); PG8_STAGE(PG8_SB(0, 0), b2, voffB); PG8_STAGE(PG8_SB(0, 1), b2 + hstep, voffB); PG8_STAGE(PG8_SA(0, 0), a2, voffA);
            PG8_WAIT_V(8); PG8_WAIT_L(0); PG8_BAR; PG8_MMA(1, 0, At, B0); PG8_MMA(1, 1, At, B1); PG8_BAR; PG8_SCHED;
            PG8_LDB(B0, 1, 0); PG8_LDB(B1, 1, 1); PG8_SCHED; PG8_LDA(At, 1, 0); PG8_STAGE(PG8_SA(0, 1), a2 + hstep, voffA);
            PG8_WAIT_V(8); PG8_WAIT_L(0); PG8_BAR; PG8_MMA(0, 0, At, B0); PG8_MMA(0, 1, At, B1); PG8_BAR; PG8_SCHED;
            PG8_LDA(At, 1, 1); PG8_STAGE(PG8_SB(1, 0), b3, voffB); PG8_STAGE(PG8_SB(1, 1), b3 + hstep, voffB); PG8_STAGE(PG8_SA(1, 0), a3, voffA);
            PG8_WAIT_V(8); PG8_WAIT_L(0); PG8_BAR; PG8_MMA(1, 0, At, B0); PG8_MMA(1, 1, At, B1); PG8_BAR; PG8_SCHED;
        }
        if (wr == 0) PG8_BAR;
        E(acc, cur, wr, wc, fr, fq);
        if (!has_next) break;
#pragma unroll
        for (int a = 0; a < 2; ++a)
#pragma unroll
            for (int b = 0; b < 2; ++b)
#pragma unroll
                for (int m = 0; m < 4; ++m)
#pragma unroll
                    for (int n = 0; n < 2; ++n) acc[a][b][m][n] = (f32x4){0.f, 0.f, 0.f, 0.f};
        cur = nxt; cA = nA; cB = nB; ++ui;
        if (wr == 1) PG8_BAR;
    }
    PG8_WAIT_V(0);
    PG8_BAR;
#undef PG8_SA
#undef PG8_SB
#undef PG8_STAGE
#undef PG8_LDA
#undef PG8_LDB
#undef PG8_MMA
#undef PG8_WAIT_V
#undef PG8_WAIT_L
#undef PG8_BAR
#undef PG8_SCHED
}
#define PG8_ROW(u, ai, m) ((u).pm * 256 + (ai) * 128 + wr * 64 + (m) * 16 + fr)
#define PG8_COL(u, bj, n) ((u).pn * 256 + (bj) * 128 + wc * 32 + fq * 8 + (n) * 4)
}

DEVI void transpose_tile(const float* __restrict__ src, int ld, bf16_t* __restrict__ dst, int K, int k0, int n0, float* tile) {
    const int tid = TID;
    const int n = tid & 63, kq = tid >> 6;
#pragma unroll 4
    for (int i = 0; i < 16; ++i) { const int k = kq * 16 + i; tile[k * 65 + n] = src[(size_t)(k0 + k) * ld + n0 + n]; }
    __syncthreads();
    const int kp = tid & 31, nq = tid >> 5;
#pragma unroll 4
    for (int i = 0; i < 8; ++i) {
        const int nn = nq * 8 + i;
        const float a = tile[(2 * kp) * 65 + nn], b = tile[(2 * kp + 1) * 65 + nn];
        *(unsigned*)&dst[(size_t)(n0 + nn) * K + k0 + 2 * kp] = pack2(a, b);
    }
    __syncthreads();
}

DEVI void phase0(const Params& p, unsigned char* smem) {
    float* tile = (float*)(smem + VHALF * SMEM_HALF);
    unsigned char* ws = p.ws;
    const int tid = TID;
    constexpr int T_IN = 640, T_OUT = 256, T_Q = 512, T_MOD = 1536, T_POOL = 16;
    constexpr int T_ALL = T_IN + T_OUT + T_Q + T_MOD + T_POOL;
    constexpr int L_KEYS = 128, L_AMOD = 128, L_POOL = 352;
    for (int it0 = blockIdx.x * 2; it0 < T_ALL; it0 += NVB) {
        int it = it0 + VHALF;
        if (it < T_IN) { transpose_tile(p.w_in, DIN, (bf16_t*)(ws + WS_WTIN), 1024, (it / 40) * 64, (it % 40) * 64, tile); continue; }
        it -= T_IN;
        if (it < T_OUT) { transpose_tile(p.w_out, 1024, (bf16_t*)(ws + WS_WTOUT), 1024, (it / 16) * 64, (it % 16) * 64, tile); continue; }
        it -= T_OUT;
        if (it < T_Q) { transpose_tile(p.w_q, 2048, (bf16_t*)(ws + WS_WTQ), 1024, (it / 32) * 64, (it % 32) * 64, tile); continue; }
        it -= T_Q;
        if (it < T_MOD) { transpose_tile(p.w_mod, NMOD, (bf16_t*)(ws + WS_WTMOD), 1024, (it / 96) * 64, (it % 96) * 64, tile); continue; }
        it -= T_MOD;
        { const int g = it >> 2, r = it & 3; transpose_tile(p.w_pool + g * 16384, 128, (bf16_t*)(ws + WS_WTPOOL) + g * 16384, 128, (r >> 1) * 64, (r & 1) * 64, tile); }
    }
    for (int item = blockIdx.x * 2 + VHALF; item < L_KEYS + L_AMOD + L_POOL; item += NVB) {
        int it = item;
        if (it < L_KEYS) {
            const size_t e = (size_t)it * 2048 + tid * 8;
            const float4 a = *(const float4*)(p.sub_keys + e), b = *(const float4*)(p.sub_keys + e + 4);
            *(uint4*)((bf16_t*)(ws + WS_KEYS) + e) = uint4{pack2(a.x, a.y), pack2(a.z, a.w), pack2(b.x, b.y), pack2(b.z, b.w)};
            continue;
        }
        it -= L_KEYS;
        if (it < L_AMOD) {
            const int row = it * 2 + (tid >> 7), col = (tid & 127) * 8;
            uint4 o = uint4{0u, 0u, 0u, 0u};
            if (row < NSEQ) {
                const float* c = (row < 8 ? p.c_prompt + (size_t)row * D : p.c_sample + (size_t)(row - 8) * D) + col;
                const float4 a = *(const float4*)c, b = *(const float4*)(c + 4);
                float v[8] = {a.x, a.y, a.z, a.w, b.x, b.y, b.z, b.w};
#pragma unroll
                for (int j = 0; j < 8; ++j) v[j] = v[j] * sigmoidf_(v[j]);
                o = uint4{pack2(v[0], v[1]), pack2(v[2], v[3]), pack2(v[4], v[5]), pack2(v[6], v[7])};
            }
            *(uint4*)((bf16_t*)(ws + WS_AMOD) + (size_t)row * D + col) = o;
            continue;
        }
        it -= L_AMOD;
        {
            const size_t e = (size_t)it * 2048 + tid * 8;
            const int b = (int)(e / (11 * 512)), r = (int)(e % (11 * 512));
            const float* sp = p.state_pool + (size_t)b * 15 * 512 + 4 * 512 + r;
            float* d = p.out + O_POOLS + (size_t)b * 15 * 512 + r;
            *(float4*)d = *(const float4*)sp; *(float4*)(d + 4) = *(const float4*)(sp + 4);
        }
    }
}

struct EpiMod {
    float* mod; const float* bias;
    DEVI void operator()(const f32x4 (&acc)[2][2][4][2], const pg8::Unit& u, int wr, int wc, int fr, int fq) const {
        f32x4 bv[2][2];
#pragma unroll
        for (int bj = 0; bj < 2; ++bj)
#pragma unroll
            for (int n = 0; n < 2; ++n) bv[bj][n] = *(const f32x4*)(bias + PG8_COL(u, bj, n));
#pragma unroll
        for (int ai = 0; ai < 2; ++ai)
#pragma unroll
            for (int m = 0; m < 4; ++m) {
                const int row = PG8_ROW(u, ai, m);
#pragma unroll
                for (int bj = 0; bj < 2; ++bj)
#pragma unroll
                    for (int n = 0; n < 2; ++n) *(f32x4*)(mod + (size_t)row * NMOD + PG8_COL(u, bj, n)) = acc[ai][bj][m][n] + bv[bj][n];
            }
    }
};
struct EpiP {
    bf16_t* P; const float* bias; float* out;
    DEVI void operator()(const f32x4 (&acc)[2][2][4][2], const pg8::Unit& u, int wr, int wc, int fr, int fq) const {
        f32x4 bv[2][2];
#pragma unroll
        for (int bj = 0; bj < 2; ++bj)
#pragma unroll
            for (int n = 0; n < 2; ++n) bv[bj][n] = *(const f32x4*)(bias + PG8_COL(u, bj, n));
#pragma unroll
        for (int ai = 0; ai < 2; ++ai)
#pragma unroll
            for (int m = 0; m < 4; ++m) {
                const int row = PG8_ROW(u, ai, m);
                float* pool_dst = nullptr;
                if (u.pn < 2) {
                    if (row < NTP) { const int t = row & (SEQ - 1); if (t >= SEQ - 15) pool_dst = out + O_POOLP + ((size_t)(row >> 11) * 15 + (t - (SEQ - 15))) * 512; }
                    else { const int r = row - NTP; pool_dst = out + O_POOLS + ((size_t)(r >> 2) * 15 + 11 + (r & 3)) * 512; }
                }
#pragma unroll
                for (int bj = 0; bj < 2; ++bj) {
                    const int col = PG8_COL(u, bj, 0);
                    const f32x4 v0 = acc[ai][bj][m][0] + bv[bj][0], v1 = acc[ai][bj][m][1] + bv[bj][1];
                    *(u32x4*)(P + (size_t)row * NP + col) = u32x4{pack2(v0[0], v0[1]), pack2(v0[2], v0[3]), pack2(v1[0], v1[1]), pack2(v1[2], v1[3])};
                    if (pool_dst) { *(f32x4*)(pool_dst + col) = v0; *(f32x4*)(pool_dst + col + 4) = v1; }
                }
            }
    }
};
struct EpiOut {
    const float* xp; const float* xs; const float* mod; float* out;
    DEVI void operator()(const f32x4 (&acc)[2][2][4][2], const pg8::Unit& u, int wr, int wc, int fr, int fq) const {
        const float* g1 = mod + (size_t)((u.pm * 256) >> 11) * NMOD + 2048;
        f32x4 gv[2][2];
#pragma unroll
        for (int bj = 0; bj < 2; ++bj)
#pragma unroll
            for (int n = 0; n < 2; ++n) gv[bj][n] = *(const f32x4*)(g1 + PG8_COL(u, bj, n)) + 1.f;
#pragma unroll
        for (int ai = 0; ai < 2; ++ai)
#pragma unroll
            for (int bj = 0; bj < 2; ++bj) {
                f32x4 xv[4][2];
#pragma unroll
                for (int m = 0; m < 4; ++m)
#pragma unroll
                    for (int n = 0; n < 2; ++n) xv[m][n] = *(const f32x4*)(xp + (size_t)PG8_ROW(u, ai, m) * D + PG8_COL(u, bj, n));
#pragma unroll
                for (int m = 0; m < 4; ++m)
#pragma unroll
                    for (int n = 0; n < 2; ++n) *(f32x4*)(out + (size_t)PG8_ROW(u, ai, m) * D + PG8_COL(u, bj, n)) = xv[m][n] * ALPHA + gv[bj][n] * acc[ai][bj][m][n];
            }
    }
};
struct EpiQ {
    bf16_t* Q;
    DEVI void operator()(const f32x4 (&acc)[2][2][4][2], const pg8::Unit& u, int wr, int wc, int fr, int fq) const {
#pragma unroll
        for (int ai = 0; ai < 2; ++ai)
#pragma unroll
            for (int m = 0; m < 4; ++m) {
                const int row = PG8_ROW(u, ai, m);
#pragma unroll
                for (int bj = 0; bj < 2; ++bj) {
                    const int col = PG8_COL(u, bj, 0);
                    const f32x4 v0 = acc[ai][bj][m][0] * 1.f, v1 = acc[ai][bj][m][1] * 1.f;
                    *(u32x4*)(Q + (size_t)row * 2048 + col) = u32x4{pack2(v0[0], v0[1]), pack2(v0[2], v0[3]), pack2(v1[0], v1[1]), pack2(v1[2], v1[3])};
                }
            }
    }
};

DEVI void phase1(const Params& p, unsigned char* smem) {
    unsigned char* ws = p.ws;
    {
        pg8::Gemm g{(const bf16_t*)(ws + WS_AMOD), (const bf16_t*)(ws + WS_WTMOD), 256, NMOD, D, D};
        pg8::StaticOrder S; S.init(256, NMOD, (int)gridDim.x, (int)blockIdx.x);
        EpiMod E{(float*)(ws + WS_MOD), p.b_mod};
        pg8::gemm_phase(( LAS unsigned char*)smem, g, S, E);
    }
    const int tid = TID, lane = tid & 63, w = tid >> 6;
    {
        for (int ci = ((int)blockIdx.x - 24) * 2 + VHALF; ci >= 0 && ci < 4096; ci += NVB - 48) {
            {
            const bool isu = ci < 2048;
            const int row0 = (ci & 2047) * 8 + w * 2;
            const float* tab = isu ? p.u_tab : p.v_tab;
            unsigned char* dst = ws + (isu ? WS_UT : WS_VT);
            float* sc = (float*)(ws + (isu ? WS_USC : WS_VSC));
#pragma unroll
            for (int r = 0; r < 2; ++r) {
                const int row = row0 + r;
                const float* src = tab + (size_t)row * D + lane * 16;
                float v[16];
#pragma unroll
                for (int i = 0; i < 4; ++i) { const float4 t = *(const float4*)(src + i * 4); v[i * 4] = t.x; v[i * 4 + 1] = t.y; v[i * 4 + 2] = t.z; v[i * 4 + 3] = t.w; }
                float am = 0.f;
#pragma unroll
                for (int i = 0; i < 16; ++i) am = fmaxf(am, fabsf(v[i]));
#pragma unroll
                for (int o = 32; o > 0; o >>= 1) am = fmaxf(am, __shfl_xor(am, o));
                if (isu && !UFP4) {
                    const float scl = am > 0.f ? 224.f / am : 1.f;
                    if (lane == 0) sc[row] = am > 0.f ? am * (1.f / 224.f) : 1.f;
                    int wd[4];
#pragma unroll
                    for (int i = 0; i < 4; ++i) {
                        int t = __builtin_amdgcn_cvt_pk_fp8_f32(v[i * 4] * scl, v[i * 4 + 1] * scl, 0, false);
                        wd[i] = __builtin_amdgcn_cvt_pk_fp8_f32(v[i * 4 + 2] * scl, v[i * 4 + 3] * scl, t, true);
                    }
                    *(int4*)(dst + (size_t)row * D + lane * 16) = int4{wd[0], wd[1], wd[2], wd[3]};
                } else {
                    const float scl = am > 0.f ? 6.f / am : 1.f;
                    if (lane == 0) sc[row] = am > 0.f ? am * (1.f / 6.f) : 1.f;
                    unsigned d0 = 0u, d1 = 0u;
                    d0 = __builtin_amdgcn_cvt_scalef32_pk_fp4_f32(d0, v[0] * scl, v[1] * scl, 1.0f, 0);
                    d0 = __builtin_amdgcn_cvt_scalef32_pk_fp4_f32(d0, v[2] * scl, v[3] * scl, 1.0f, 1);
                    d0 = __builtin_amdgcn_cvt_scalef32_pk_fp4_f32(d0, v[4] * scl, v[5] * scl, 1.0f, 2);
                    d0 = __builtin_amdgcn_cvt_scalef32_pk_fp4_f32(d0, v[6] * scl, v[7] * scl, 1.0f, 3);
                    d1 = __builtin_amdgcn_cvt_scalef32_pk_fp4_f32(d1, v[8] * scl, v[9] * scl, 1.0f, 0);
                    d1 = __builtin_amdgcn_cvt_scalef32_pk_fp4_f32(d1, v[10] * scl, v[11] * scl, 1.0f, 1);
                    d1 = __builtin_amdgcn_cvt_scalef32_pk_fp4_f32(d1, v[12] * scl, v[13] * scl, 1.0f, 2);
                    d1 = __builtin_amdgcn_cvt_scalef32_pk_fp4_f32(d1, v[14] * scl, v[15] * scl, 1.0f, 3);
                    *(uint2*)(dst + (size_t)row * 512 + lane * 8) = uint2{d0, d1};
                }
            }
        }
    }
    }
}

DEVI void phase2(const Params& p, unsigned char* smem) {
    unsigned char* ws = p.ws;
    const int tid = threadIdx.x, lane = tid & 63, w = tid >> 6;
    const float* mod = (const float*)(ws + WS_MOD);
    bf16_t* u1 = (bf16_t*)(ws + WS_BUFA);
    float* gates = (float*)(ws + WS_GATES);
    float* Wg = (float*)smem;
    for (int k = tid; k < 1024; k += 512) {
        const float4 w0 = *(const float4*)(p.w_in + (size_t)k * DIN + NP), w1 = *(const float4*)(p.w_in + (size_t)k * DIN + NP + 4);
        Wg[k] = w0.x; Wg[1024 + k] = w0.y; Wg[2048 + k] = w0.z; Wg[3072 + k] = w0.w;
        Wg[4096 + k] = w1.x; Wg[5120 + k] = w1.y; Wg[6144 + k] = w1.z; Wg[7168 + k] = w1.w;
    }
    __syncthreads();
    const int nw = gridDim.x * 8;
    for (int tok0 = blockIdx.x * 8 + w; tok0 < NT; tok0 += 2 * nw) {
      float vv[2][16];
      const bool has2 = tok0 + nw < NT;
#pragma unroll
      for (int t = 0; t < 2; ++t) {
          const float* x = xrow_ptr(p, (t == 0 || has2) ? tok0 + t * nw : tok0);
#pragma unroll
          for (int i = 0; i < 4; ++i) { const float4 q4 = *(const float4*)(x + i * 256 + lane * 4); vv[t][i * 4] = q4.x; vv[t][i * 4 + 1] = q4.y; vv[t][i * 4 + 2] = q4.z; vv[t][i * 4 + 3] = q4.w; }
      }
#pragma unroll
      for (int t = 0; t < 2; ++t) {
        if (t == 1 && !has2) break;
        const int tok = tok0 + t * nw;
        const float* ms = mod + (size_t)seq_of(tok) * NMOD;
        float v[16];
#pragma unroll
        for (int i = 0; i < 16; ++i) v[i] = vv[t][i];
        float s = 0.f;
#pragma unroll
        for (int i = 0; i < 16; ++i) s += v[i];
        const float mean = wave_sum(s) * (1.f / 1024.f);
        float q = 0.f;
#pragma unroll
        for (int i = 0; i < 16; ++i) { v[i] -= mean; q += v[i] * v[i]; }
        const float rstd = rsqrtf(wave_sum(q) * (1.f / 1024.f) + LN_EPS);
        float g[8] = {0.f, 0.f, 0.f, 0.f, 0.f, 0.f, 0.f, 0.f};
#pragma unroll
        for (int i = 0; i < 4; ++i) {
            const int c = i * 256 + lane * 4;
            const float4 sh = *(const float4*)(ms + c), sc = *(const float4*)(ms + 1024 + c);
            float u[4];
            u[0] = v[i * 4] * rstd * (1.f + sc.x) + sh.x; u[1] = v[i * 4 + 1] * rstd * (1.f + sc.y) + sh.y;
            u[2] = v[i * 4 + 2] * rstd * (1.f + sc.z) + sh.z; u[3] = v[i * 4 + 3] * rstd * (1.f + sc.w) + sh.w;
            *(uint2*)(u1 + (size_t)tok * D + c) = uint2{pack2(u[0], u[1]), pack2(u[2], u[3])};
#pragma unroll
            for (int gg = 0; gg < 8; ++gg) {
                const float4 wv = *(const float4*)&Wg[gg * 1024 + c];
                g[gg] += u[0] * wv.x + u[1] * wv.y + u[2] * wv.z + u[3] * wv.w;
            }
        }
#pragma unroll
        for (int j = 0; j < 8; ++j) g[j] = wave_sum(g[j]);
        if (lane == 0) {
            const float4 b0 = *(const float4*)(p.b_in + NP), b1 = *(const float4*)(p.b_in + NP + 4);
            *(float4*)(gates + (size_t)tok * 8) = float4{g[0] + b0.x, g[1] + b0.y, g[2] + b0.z, g[3] + b0.w};
            *(float4*)(gates + (size_t)tok * 8 + 4) = float4{g[4] + b1.x, g[5] + b1.y, g[6] + b1.z, g[7] + b1.w};
        }
      }
    }
}

DEVI void phase3(const Params& p, unsigned char* smem) {
    unsigned char* ws = p.ws;
    const int lane = threadIdx.x & 63;
    pg8::Gemm g{(const bf16_t*)(ws + WS_BUFA), (const bf16_t*)(ws + WS_WTIN), NT, NP, D, D};
    pg8::StaticOrder S; S.init(NT, NP, (int)gridDim.x, (int)blockIdx.x);
    EpiP E{(bf16_t*)(ws + WS_P), p.b_in, p.out};
    pg8::gemm_phase((LAS unsigned char*)smem, g, S, E);
    if ((int)blockIdx.x >= (int)gridDim.x - 32 && (threadIdx.x >> 6) == 0) {
        const int bh = (int)blockIdx.x - ((int)gridDim.x - 32), b = bh >> 2, h = bh & 3;
        const float* gates = (const float*)(ws + WS_GATES);
        float* mst = (float*)(ws + WS_MST) + bh * 64;
        float m = 0.f;
        for (int c = 0; c < 32; ++c) {
            const int tok = b * SEQ + c * 64 + lane;
            const float gi = gates[(size_t)tok * 8 + h], gf = gates[(size_t)tok * 8 + 4 + h];
            const float bb = scan_sum_incl(logsigmoid(gf), lane);
            const float R = scan_max_incl(gi - bb, lane);
            const float B63 = __shfl(bb, 63), R63 = __shfl(R, 63);
            {
                const int ti = bh * 2048 + c * 64 + lane;
                ((float*)(ws + WS_GA))[ti] = B63 - bb + gi; ((float*)(ws + WS_BB))[ti] = bb;
                ((float*)(ws + WS_RR))[ti] = gi - bb; ((float*)(ws + WS_RPM))[ti] = R;
                if (lane == 0) ((float*)(ws + WS_BCH))[bh * 32 + c] = B63;
            }
            if (lane == 0) mst[c] = m;
            m = B63 + fmaxf(m, R63);
        }
        if (lane == 0) { mst[32] = m; p.out[O_MP + bh] = m; }
    }
}

#define LDS_BAR() do { asm volatile("s_waitcnt lgkmcnt(0)" ::: "memory"); __builtin_amdgcn_s_barrier(); asm volatile("" ::: "memory"); } while (0)
DEVI void p4_state_scan(const Params& p, unsigned char* smem, int it) {
    unsigned char* ws = p.ws;
    const int tid = TID, lane = tid & 63, w = tid >> 6, fr = lane & 15, fq = lane >> 4;
    const int bh = it >> 3, sl = it & 7, b = bh >> 2, h = bh & 3;
    bf16_t* Ks = (bf16_t*)smem;
    bf16_t* Vs = (bf16_t*)(smem + 64 * LDW * 2);
    float* gin = (float*)(smem + 64 * LDW * 2 + 64 * 24 * 2);
    const bf16_t* P = (const bf16_t*)(ws + WS_P);
    const float* gates = (const float*)(ws + WS_GATES);
    const float* mst = (const float*)(ws + WS_MST) + bh * 64;
    bf16_t* ST = (bf16_t*)(ws + WS_BUFB) + (size_t)bh * 32 * 16384;
    float* nst = (float*)(ws + WS_NST) + (size_t)bh * 32 * 128;
    f32x4 acc[2] = {f32x4{0.f, 0.f, 0.f, 0.f}, f32x4{0.f, 0.f, 0.f, 0.f}};
    float nacc = 0.f;
    u32x4 ka0, ka1, ka2, ka3, va = u32x4{0u, 0u, 0u, 0u}; float gia = 0.f, gfa = 0.f;
    u32x4 kb0, kb1, kb2, kb3, vb_ = u32x4{0u, 0u, 0u, 0u}; float gib = 0.f, gfb = 0.f;
    const int ks_ = tid >> 4, kc_ = tid & 15;
#define P4_PREFETCH(c, K0, K1, K2, K3, VR, GI, GF) do { const int _t0 = b * SEQ + (c) * 64; \
        { const bf16_t* _kp = P + (size_t)(_t0 + ks_) * NP + 1024 + h * 128 + kc_ * 8; \
          K0 = *(const u32x4*)(_kp); K1 = *(const u32x4*)(_kp + (size_t)16 * NP); K2 = *(const u32x4*)(_kp + (size_t)32 * NP); K3 = *(const u32x4*)(_kp + (size_t)48 * NP); } \
        if (tid < 128) VR = *(const u32x4*)(P + (size_t)(_t0 + (tid >> 1)) * NP + 1536 + h * 128 + sl * 16 + (tid & 1) * 8); \
        if (w == 0) { GI = ((const float*)(ws + WS_GA))[bh * 2048 + (c) * 64 + lane]; GF = ((const float*)(ws + WS_BCH))[bh * 32 + (c)]; } } while (0)
#define P4_STEP(c, K0, K1, K2, K3, VR, GI, GF) do { \
        if (w == 0) { \
            const float mc = mst[(c)], mn = mst[(c) + 1]; \
            gin[lane] = expf(GI - mn) * KSCALE; \
            if (lane == 0) gin[64] = expf(GF + mc - mn); \
        } \
        *(u32x4*)&Ks[ks_ * LDW + kc_ * 8] = K0; *(u32x4*)&Ks[(ks_ + 16) * LDW + kc_ * 8] = K1; \
        *(u32x4*)&Ks[(ks_ + 32) * LDW + kc_ * 8] = K2; *(u32x4*)&Ks[(ks_ + 48) * LDW + kc_ * 8] = K3; \
        const u32x4 v = VR; \
        LDS_BAR(); \
        if ((c) + 2 < 32) P4_PREFETCH((c) + 2, K0, K1, K2, K3, VR, GI, GF); \
        { \
            bf16_t* STc = ST + (size_t)(c) * 16384; \
            _Pragma("unroll") for (int mt = 0; mt < 2; ++mt) { \
                const int d0 = (w * 2 + mt) * 16 + fq * 4, e = sl * 16 + fr; \
                *(uint2*)(STc + e * 128 + d0) = uint2{pack2(acc[mt][0], acc[mt][1]), pack2(acc[mt][2], acc[mt][3])}; \
            } \
            if (w == 0 && lane < 16) nst[(c) * 128 + sl * 16 + lane] = nacc; \
        } \
        const float gprev = gin[64]; \
        if (tid < 128) { \
            const int s_ = tid >> 1, hf = tid & 1; \
            const float g = gin[s_]; \
            *(uint4*)&Vs[s_ * 24 + hf * 8] = uint4{pack2(bf_lo(v.x) * g, bf_hi(v.x) * g), pack2(bf_lo(v.y) * g, bf_hi(v.y) * g), \
                                                    pack2(bf_lo(v.z) * g, bf_hi(v.z) * g), pack2(bf_lo(v.w) * g, bf_hi(v.w) * g)}; \
        } \
        if (w == 0) { \
            const int d = sl * 16 + fr; \
            float a = 0.f; \
            _Pragma("unroll") for (int s_ = 0; s_ < 16; ++s_) a += bf1(Ks[(fq * 16 + s_) * LDW + d]) * gin[fq * 16 + s_]; \
            nacc = gprev * nacc + sumq(a); \
        } \
        LDS_BAR(); \
        _Pragma("unroll") for (int mt = 0; mt < 2; ++mt) { acc[mt][0] *= gprev; acc[mt][1] *= gprev; acc[mt][2] *= gprev; acc[mt][3] *= gprev; } \
        _Pragma("unroll") for (int ks = 0; ks < 2; ++ks) { \
            const bf16x8 vfr = tr_frag(Vs, 24, ks * 32, 0, lane); \
            _Pragma("unroll") for (int mt = 0; mt < 2; ++mt) { \
                const bf16x8 ka = tr_frag(Ks, LDW, ks * 32, (w * 2 + mt) * 16, lane); \
                acc[mt] = __builtin_amdgcn_mfma_f32_16x16x32_bf16(ka, vfr, acc[mt], 0, 0, 0); \
            } \
        } \
        LDS_BAR(); } while (0)
    P4_PREFETCH(0, ka0, ka1, ka2, ka3, va, gia, gfa);
    P4_PREFETCH(1, kb0, kb1, kb2, kb3, vb_, gib, gfb);
    for (int c = 0; c < 32; c += 2) {
        P4_STEP(c, ka0, ka1, ka2, ka3, va, gia, gfa);
        P4_STEP(c + 1, kb0, kb1, kb2, kb3, vb_, gib, gfb);
    }
#undef P4_STEP
#undef P4_PREFETCH
    float* Cp = p.out + O_CP + (size_t)bh * 16384;
#pragma unroll
    for (int mt = 0; mt < 2; ++mt)
#pragma unroll
        for (int j = 0; j < 4; ++j) Cp[((w * 2 + mt) * 16 + fq * 4 + j) * 128 + sl * 16 + fr] = acc[mt][j];
    if (w == 0 && lane < 16) p.out[O_NP + bh * 128 + sl * 16 + lane] = nacc;
}

DEVI void p4_sample(const Params& p, unsigned char* smem, int it) {
    unsigned char* ws = p.ws;
    const int tid = TID, lane = tid & 63, w = tid >> 6;
    const int b = it >> 2, h = it & 3;
    float* qs = (float*)smem;
    float* kg = qs + 512;
    float* vs = kg + 512;
    float* ksc = vs + 512;
    float* qS = ksc + 512;
    float* Pm = qS + 1024;
    float* qn = Pm + 16;
    const bf16_t* P = (const bf16_t*)(ws + WS_P);
    const float* gates = (const float*)(ws + WS_GATES);
    const int tok0 = NTP + b * 4;
    float gi[4], bb[4], mt_[4];
    const float m0 = p.state_m[b * 4 + h];
    {
        float cum = 0.f, R = -INFINITY;
#pragma unroll
        for (int s = 0; s < 4; ++s) {
            gi[s] = gates[(size_t)(tok0 + s) * 8 + h];
            cum += logsigmoid(gates[(size_t)(tok0 + s) * 8 + 4 + h]);
            bb[s] = cum; R = fmaxf(R, gi[s] - cum);
            mt_[s] = cum + fmaxf(m0, R);
        }
    }
    const float mnew = mt_[3];
    const float gprev = expf(bb[3] + m0 - mnew);
    float gin[4];
#pragma unroll
    for (int s = 0; s < 4; ++s) gin[s] = expf(bb[3] - bb[s] + gi[s] - mnew);
    {
        const int t = tid >> 6, dd = (tid & 63) * 2;
        const bf16_t* row = P + (size_t)(tok0 + t) * NP + h * 128 + dd;
        const unsigned uq = *(const unsigned*)(row + 512), uk = *(const unsigned*)(row + 1024), uv = *(const unsigned*)(row + 1536);
        float g = gin[0]; g = t == 1 ? gin[1] : g; g = t == 2 ? gin[2] : g; g = t == 3 ? gin[3] : g;
        qs[t * 128 + dd] = bf_lo(uq); qs[t * 128 + dd + 1] = bf_hi(uq);
        const float k0 = bf_lo(uk) * KSCALE, k1 = bf_hi(uk) * KSCALE;
        ksc[t * 128 + dd] = k0; ksc[t * 128 + dd + 1] = k1;
        kg[t * 128 + dd] = k0 * g; kg[t * 128 + dd + 1] = k1 * g;
        vs[t * 128 + dd] = bf_lo(uv); vs[t * 128 + dd + 1] = bf_hi(uv);
    }
    __syncthreads();
    const int e = tid & 127, dh = tid >> 7;
    const float* S0 = p.state_C + (size_t)(b * 4 + h) * 16384;
    float* Cs = p.out + O_CS + (size_t)(b * 4 + h) * 16384;
    const float v0 = vs[e], v1 = vs[128 + e], v2 = vs[256 + e], v3 = vs[384 + e];
    float a0 = 0.f, a1 = 0.f, a2 = 0.f, a3 = 0.f;
    for (int hh = 0; hh < 4; ++hh) {
    float Sv[16];
#pragma unroll
    for (int i = 0; i < 16; ++i) Sv[i] = S0[(dh * 64 + hh * 16 + i) * 128 + e];
#pragma unroll
    for (int i = 0; i < 16; ++i) {
        const int d = dh * 64 + hh * 16 + i;
        const float S = Sv[i];
        a0 += qs[d] * S; a1 += qs[128 + d] * S; a2 += qs[256 + d] * S; a3 += qs[384 + d] * S;
        Cs[d * 128 + e] = gprev * S + kg[d] * v0 + kg[128 + d] * v1 + kg[256 + d] * v2 + kg[384 + d] * v3;
    }
    }
    qS[(dh * 4 + 0) * 128 + e] = a0; qS[(dh * 4 + 1) * 128 + e] = a1; qS[(dh * 4 + 2) * 128 + e] = a2; qS[(dh * 4 + 3) * 128 + e] = a3;
    {
        const int t = w;
        const float* n0 = p.state_n + (size_t)(b * 4 + h) * 128;
        const float q0 = qs[t * 128 + lane], q1 = qs[t * 128 + 64 + lane];
        const float qn_ = wave_sum(q0 * n0[lane] + q1 * n0[64 + lane]);
        if (lane == 0) qn[t] = qn_;
#pragma unroll
        for (int s = 0; s < 4; ++s) {
            const float d = wave_sum(q0 * ksc[s * 128 + lane] + q1 * ksc[s * 128 + 64 + lane]);
            if (lane == 0) Pm[t * 4 + s] = (s <= t) ? d * expf(bb[t] - bb[s] + gi[s] - mt_[t]) : 0.f;
        }
        if (t == 0) {
            const float n_a = gprev * n0[lane] + kg[lane] + kg[128 + lane] + kg[256 + lane] + kg[384 + lane];
            const float n_b = gprev * n0[64 + lane] + kg[64 + lane] + kg[192 + lane] + kg[320 + lane] + kg[448 + lane];
            p.out[O_NS + (size_t)(b * 4 + h) * 128 + lane] = n_a;
            p.out[O_NS + (size_t)(b * 4 + h) * 128 + 64 + lane] = n_b;
            if (lane == 0) p.out[O_MS + b * 4 + h] = mnew;
        }
    }
    __syncthreads();
    {
        const int t = w;
        const float wprev = expf(bb[t] + m0 - mt_[t]);
        const float p0 = Pm[t * 4], p1 = Pm[t * 4 + 1], p2 = Pm[t * 4 + 2], p3 = Pm[t * 4 + 3];
        const float den = wprev * qn[t] + p0 + p1 + p2 + p3;
        const float inv = 1.f / fmaxf(fabsf(den), expf(-mt_[t]));
        float hv[2];
#pragma unroll
        for (int r = 0; r < 2; ++r) {
            const int ee = lane + 64 * r;
            const float num = wprev * (qS[t * 128 + ee] + qS[(4 + t) * 128 + ee]) + p0 * vs[ee] + p1 * vs[128 + ee] + p2 * vs[256 + ee] + p3 * vs[384 + ee];
            hv[r] = num * inv;
        }
        const float mean = wave_sum(hv[0] + hv[1]) * (1.f / 128.f);
        const float c0 = hv[0] - mean, c1 = hv[1] - mean;
        const float rstd = rsqrtf(wave_sum(c0 * c0 + c1 * c1) * (1.f / 128.f) + LN_EPS);
        bf16_t* ym = (bf16_t*)(ws + WS_BUFA) + (size_t)(tok0 + t) * D + 512 + h * 128;
        const bf16_t* orow = P + (size_t)(tok0 + t) * NP + 2048 + h * 128;
#pragma unroll
        for (int r = 0; r < 2; ++r) {
            const int ee = lane + 64 * r;
            const float y = (r ? c1 : c0) * rstd * p.mh_norm_g[h * 128 + ee] * sigmoidf_(bf1(orow[ee]));
            ym[ee] = (bf16_t)(pack2(y, 0.f) & 0xFFFFu);
        }
    }
    __syncthreads();
}

DEVI void p4_pool(const Params& p, unsigned char* smem, int it) {
    unsigned char* ws = p.ws;
    const int tid = TID, lane = tid & 63, w = tid >> 6, wr = w >> 1, wc = w & 1, fr = lane & 15, fq = lane >> 4;
    const int tt = it >> 2, g = it & 3, win = 2 << g;
    bf16_t* Ad = (bf16_t*)smem;
    bf16_t* Bw = (bf16_t*)(smem + 128 * LDW * 2);
    const bf16_t* P = (const bf16_t*)(ws + WS_P);
#pragma unroll
    for (int i = 0; i < 8; ++i) {
        const int ch = tid + i * 256, r = ch >> 4, kc = ch & 15;
        *(uint4*)&Bw[r * LDW + kc * 8] = *(const uint4*)((const bf16_t*)(ws + WS_WTPOOL) + g * 16384 + r * 128 + kc * 8);
    }
    const int c4 = (tid & 31) * 4;
    if (tt < 128) {
        const int r0 = (tid >> 5) * 16;
        const int tokb = tt * 128 + r0;
        const int t0 = tokb & (SEQ - 1);
        const bf16_t* col = P + g * 128 + c4;
        float s0 = 0.f, s1 = 0.f, s2 = 0.f, s3 = 0.f;
        {
            uint2 zh[15];
#pragma unroll
            for (int k = 1; k < 16; ++k) zh[k - 1] = (k < win && t0 - k >= 0) ? *(const uint2*)(col + (size_t)(tokb - k) * NP) : uint2{0u, 0u};
#pragma unroll
            for (int k = 0; k < 15; ++k) { s0 += bf_lo(zh[k].x); s1 += bf_hi(zh[k].x); s2 += bf_lo(zh[k].y); s3 += bf_hi(zh[k].y); }
        }
        for (int hp = 0; hp < 2; ++hp) {
            uint2 zz[8], zo[8];
#pragma unroll
            for (int i = 0; i < 8; ++i) {
                const int ii = hp * 8 + i;
                zz[i] = *(const uint2*)(col + (size_t)(tokb + ii) * NP);
                zo[i] = (t0 + ii - win + 1 >= 0) ? *(const uint2*)(col + (size_t)(tokb + ii - win + 1) * NP) : uint2{0u, 0u};
            }
#pragma unroll
            for (int i = 0; i < 8; ++i) {
                const int ii = hp * 8 + i, t = t0 + ii;
                const float u0 = bf_lo(zz[i].x), u1 = bf_hi(zz[i].x), u2 = bf_lo(zz[i].y), u3 = bf_hi(zz[i].y);
                s0 += u0; s1 += u1; s2 += u2; s3 += u3;
                const float ic = 1.f / (float)min(t + 1, win);
                *(uint2*)&Ad[(r0 + ii) * LDW + c4] = uint2{pack2(s0 * ic - u0, s1 * ic - u1), pack2(s2 * ic - u2, s3 * ic - u3)};
                s0 -= bf_lo(zo[i].x); s1 -= bf_hi(zo[i].x); s2 -= bf_lo(zo[i].y); s3 -= bf_hi(zo[i].y);
            }
        }
    } else {
        const float ic = 1.f / (float)win;
        for (int i = 0; i < 4; ++i) {
            const int sq = (tid >> 5) * 4 + i;
            const int b = (tt - 128) * 32 + sq;
            const float* buf = p.state_pool + (size_t)b * 15 * 512 + g * 128 + c4;
            const bf16_t* col = P + (size_t)(NTP + b * 4) * NP + g * 128 + c4;
            float s0 = 0.f, s1 = 0.f, s2 = 0.f, s3 = 0.f;
            for (int k = 1; k < win; ++k) { const float4 z = *(const float4*)(buf + (15 - k) * 512); s0 += z.x; s1 += z.y; s2 += z.z; s3 += z.w; }
            for (int t = 0; t < 4; ++t) {
                const uint2 z = *(const uint2*)(col + (size_t)t * NP);
                const float u0 = bf_lo(z.x), u1 = bf_hi(z.x), u2 = bf_lo(z.y), u3 = bf_hi(z.y);
                s0 += u0; s1 += u1; s2 += u2; s3 += u3;
                *(uint2*)&Ad[(sq * 4 + t) * LDW + c4] = uint2{pack2(s0 * ic - u0, s1 * ic - u1), pack2(s2 * ic - u2, s3 * ic - u3)};
                const int zi = 15 + t - win + 1;
                if (zi < 15) { const float4 zo = *(const float4*)(buf + zi * 512); s0 -= zo.x; s1 -= zo.y; s2 -= zo.z; s3 -= zo.w; }
                else { const uint2 zo = *(const uint2*)(col + (size_t)(zi - 15) * NP); s0 -= bf_lo(zo.x); s1 -= bf_hi(zo.x); s2 -= bf_lo(zo.y); s3 -= bf_hi(zo.y); }
            }
        }
    }
    __syncthreads();
    f32x4 acc[4][4];
    mma_lds128(Ad, Bw, acc);
    bf16_t* ym = (bf16_t*)(ws + WS_BUFA);
#pragma unroll
    for (int m = 0; m < 4; ++m) {
        const int row = tt * 128 + wr * 64 + m * 16 + fr;
#pragma unroll
        for (int n = 0; n < 4; ++n) {
            const int col = g * 128 + wc * 64 + n * 16 + fq * 4;
            const float4 ps = *(const float4*)(p.pool_scale + col);
            *(uint2*)(ym + (size_t)row * D + col) = uint2{pack2(acc[m][n][0] * ps.x, acc[m][n][1] * ps.y), pack2(acc[m][n][2] * ps.z, acc[m][n][3] * ps.w)};
        }
    }
    __syncthreads();
}

DEVI void phase4(const Params& p, unsigned char* smem_all) {
    unsigned char* smem = smem_all + VHALF * SMEM_HALF;
    for (int it0 = (int)blockIdx.x * 2; it0 < 512; it0 += NVB) p4_sample(p, smem, it0 + VHALF);
    const int nscan = min(128, (int)gridDim.x / 2);
    if ((int)blockIdx.x < nscan) { for (int it0 = (int)blockIdx.x * 2; it0 < 256; it0 += nscan * 2) p4_state_scan(p, smem, it0 + VHALF); return; }
    const int rb = (int)blockIdx.x - nscan, nrb = ((int)gridDim.x - nscan) * 2;
    for (int it0 = rb * 2; it0 < 528; it0 += nrb) p4_pool(p, smem, it0 + VHALF);
}

DEVI void phase5(const Params& p, unsigned char* smem_all) {
    unsigned char* smem = smem_all + VHALF * SMEM_HALF;
    unsigned char* ws = p.ws;
    const int tid = TID, lane = tid & 63, w = tid >> 6, fr = lane & 15, fq = lane >> 4;
    bf16_t* Ks = (bf16_t*)smem;
    bf16_t* Vs = (bf16_t*)(smem + 64 * LDW * 2);
    bf16_t* Ps = (bf16_t*)(smem + 2 * 64 * LDW * 2) + w * 16 * LDT;
    const bf16_t* P = (const bf16_t*)(ws + WS_P);
    const float* gates = (const float*)(ws + WS_GATES);
    for (int it0 = blockIdx.x * 2; it0 < 1024; it0 += NVB) {
        const int item = it0 + VHALF;
        const int bh = item >> 5, c = item & 31, b = bh >> 2, h = bh & 3;
        const int tok0 = b * SEQ + c * 64;
        const float gi = gates[(size_t)(tok0 + lane) * 8 + h], gf = gates[(size_t)(tok0 + lane) * 8 + 4 + h];
        const float bb = scan_sum_incl(logsigmoid(gf), lane);
        const float rr = gi - bb;
        const float R = scan_max_incl(rr, lane);
        const float mc = ((const float*)(ws + WS_MST))[bh * 64 + c];
        const float mt_all = bb + fmaxf(mc, R);
        const int trow = w * 16 + fr;
        const float bt = __shfl(bb, trow), mt = __shfl(mt_all, trow);
#pragma unroll
        for (int i = 0; i < 4; ++i) {
            const int ch = tid + i * 256, s = ch >> 4, kc = ch & 15;
            const bf16_t* src = P + (size_t)(tok0 + s) * NP + h * 128 + kc * 8;
            *(uint4*)&Ks[s * LDW + kc * 8] = *(const uint4*)(src + 1024);
            *(uint4*)&Vs[s * LDW + kc * 8] = *(const uint4*)(src + 1536);
        }
        bf16x8 qa[4];
        const bf16_t* qrow = P + (size_t)(tok0 + trow) * NP + 512 + h * 128 + fq * 8;
#pragma unroll
        for (int ks = 0; ks < 4; ++ks) qa[ks] = *(const bf16x8*)(qrow + ks * 32);
        __syncthreads();
        f32x4 sacc[4];
#pragma unroll
        for (int nt = 0; nt < 4; ++nt) {
            sacc[nt] = f32x4{0.f, 0.f, 0.f, 0.f};
#pragma unroll
            for (int ks = 0; ks < 4; ++ks) {
                const bf16x8 kb = *(const bf16x8*)&Ks[(nt * 16 + fr) * LDW + ks * 32 + fq * 8];
                sacc[nt] = __builtin_amdgcn_mfma_f32_16x16x32_bf16(kb, qa[ks], sacc[nt], 0, 0, 0);
            }
        }
        float rowsum = 0.f;
#pragma unroll
        for (int nt = 0; nt < 4; ++nt) {
            float pv[4];
#pragma unroll
            for (int j = 0; j < 4; ++j) {
                const int s = nt * 16 + fq * 4 + j;
                const float rs = __shfl(rr, s);
                const float dd = (s <= trow) ? expf(bt - mt + rs) : 0.f;
                pv[j] = sacc[nt][j] * KSCALE * dd;
                rowsum += pv[j];
            }
            *(uint2*)&Ps[fr * LDT + nt * 16 + fq * 4] = uint2{pack2(pv[0], pv[1]), pack2(pv[2], pv[3])};
        }
        rowsum = sumq(rowsum);
        float qn = 0.f;
        {
            const float* nc = (const float*)(ws + WS_NST) + (size_t)(bh * 32 + c) * 128 + fq * 8;
#pragma unroll
            for (int ks = 0; ks < 4; ++ks) {
                const float4 n0 = *(const float4*)(nc + ks * 32), n1 = *(const float4*)(nc + ks * 32 + 4);
                const u32x4 qq = __builtin_bit_cast(u32x4, qa[ks]);
                qn += bf_lo(qq.x) * n0.x + bf_hi(qq.x) * n0.y + bf_lo(qq.y) * n0.z + bf_hi(qq.y) * n0.w
                    + bf_lo(qq.z) * n1.x + bf_hi(qq.z) * n1.y + bf_lo(qq.w) * n1.z + bf_hi(qq.w) * n1.w;
            }
            qn = sumq(qn);
        }
        f32x4 oacc[8];
        const bf16_t* STc = (const bf16_t*)(ws + WS_BUFB) + (size_t)(bh * 32 + c) * 16384;
#pragma unroll
        for (int nt = 0; nt < 8; ++nt) {
            oacc[nt] = f32x4{0.f, 0.f, 0.f, 0.f};
#pragma unroll
            for (int ks = 0; ks < 4; ++ks) {
                const bf16x8 sb = *(const bf16x8*)(STc + (nt * 16 + fr) * 128 + ks * 32 + fq * 8);
                oacc[nt] = __builtin_amdgcn_mfma_f32_16x16x32_bf16(sb, qa[ks], oacc[nt], 0, 0, 0);
            }
            if (nt & 1) asm volatile("" ::: "memory");
        }
        const float wprev = expf(bt + mc - mt);
#pragma unroll
        for (int nt = 0; nt < 8; ++nt) { oacc[nt][0] *= wprev; oacc[nt][1] *= wprev; oacc[nt][2] *= wprev; oacc[nt][3] *= wprev; }
        __syncthreads();
#pragma unroll
        for (int ks = 0; ks < 2; ++ks) {
            const bf16x8 pf = *(const bf16x8*)&Ps[fr * LDT + ks * 32 + fq * 8];
#pragma unroll
            for (int nt = 0; nt < 8; ++nt) {
                const bf16x8 vt = tr_frag(Vs, LDW, ks * 32, nt * 16, lane);
                oacc[nt] = __builtin_amdgcn_mfma_f32_16x16x32_bf16(vt, pf, oacc[nt], 0, 0, 0);
            }
        }
        const float den = wprev * qn + rowsum;
        const float inv = 1.f / fmaxf(fabsf(den), expf(-mt));
        float s1 = 0.f;
#pragma unroll
        for (int nt = 0; nt < 8; ++nt)
#pragma unroll
            for (int j = 0; j < 4; ++j) { oacc[nt][j] *= inv; s1 += oacc[nt][j]; }
        const float mean = sumq(s1) * (1.f / 128.f);
        float s2 = 0.f;
#pragma unroll
        for (int nt = 0; nt < 8; ++nt)
#pragma unroll
            for (int j = 0; j < 4; ++j) { oacc[nt][j] -= mean; s2 += oacc[nt][j] * oacc[nt][j]; }
        const float rstd = rsqrtf(sumq(s2) * (1.f / 128.f) + LN_EPS);
        bf16_t* ym = (bf16_t*)(ws + WS_BUFA) + (size_t)(tok0 + trow) * D + 512 + h * 128;
        const bf16_t* orow = P + (size_t)(tok0 + trow) * NP + 2048 + h * 128;
#pragma unroll
        for (int nt = 0; nt < 8; ++nt) {
            const int e = nt * 16 + fq * 4;
            const float4 gg = *(const float4*)(p.mh_norm_g + h * 128 + e);
            const uint2 oo = *(const uint2*)(orow + e);
            const float y0 = oacc[nt][0] * rstd * gg.x * sigmoidf_(bf_lo(oo.x)), y1 = oacc[nt][1] * rstd * gg.y * sigmoidf_(bf_hi(oo.x));
            const float y2 = oacc[nt][2] * rstd * gg.z * sigmoidf_(bf_lo(oo.y)), y3 = oacc[nt][3] * rstd * gg.w * sigmoidf_(bf_hi(oo.y));
            *(uint2*)(ym + e) = uint2{pack2(y0, y1), pack2(y2, y3)};
        }
        __syncthreads();
    }
}

struct EpiOutPart {
    const float* xs; const float* mod; float* out; float* part; int ks;
    DEVI void operator()(const f32x4 (&acc)[2][2][4][2], const pg8::Unit& u, int wr, int wc, int fr, int fq) const {
#pragma unroll
        for (int ai = 0; ai < 2; ++ai)
#pragma unroll
            for (int m = 0; m < 4; ++m) {
                const int row = PG8_ROW(u, ai, m), rs = row - NTP;
                const float* x = xs + (size_t)rs * D;
                const float* g1 = mod + (size_t)seq_of(row) * NMOD + 2048;
                float* dst = ks == 0 ? out + (size_t)row * D : part + ((size_t)(ks - 1) * NTS + rs) * D;
                f32x4 xv[2][2], gv[2][2];
#pragma unroll
                for (int bj = 0; bj < 2; ++bj)
#pragma unroll
                    for (int n = 0; n < 2; ++n) { const int col = PG8_COL(u, bj, n); gv[bj][n] = *(const f32x4*)(g1 + col); xv[bj][n] = ks == 0 ? *(const f32x4*)(x + col) * ALPHA : f32x4{0.f, 0.f, 0.f, 0.f}; }
#pragma unroll
                for (int bj = 0; bj < 2; ++bj)
#pragma unroll
                    for (int n = 0; n < 2; ++n) *(f32x4*)(dst + PG8_COL(u, bj, n)) = xv[bj][n] + (gv[bj][n] + 1.f) * acc[ai][bj][m][n];
            }
    }
};

DEVI void phase6(const Params& p, unsigned char* smem) {
    unsigned char* ws = p.ws;
    {
        pg8::Gemm g{(const bf16_t*)(ws + WS_BUFA), (const bf16_t*)(ws + WS_WTOUT), NTP, D, D, D};
        pg8::StaticOrder S; S.init(NTP, D, (int)gridDim.x, (int)blockIdx.x);
        EpiOut E{p.x_prompt, p.x_sample, (const float*)(ws + WS_MOD), p.out};
        pg8::gemm_phase((LAS unsigned char*)smem, g, S, E);
    }
    {
        const int q = (int)blockIdx.x - ((int)gridDim.x - 32);
        const int qq = q < 0 ? 0 : q, ks = qq & 3;
        pg8::Gemm g{(const bf16_t*)(ws + WS_BUFA) + ks * 256, (const bf16_t*)(ws + WS_WTOUT) + ks * 256, NT, D, 256, D};
        pg8::OneUnit S{q >= 0, pg8::Unit{64 + (qq >> 4), (qq >> 2) & 3}};
        EpiOutPart E{p.x_sample, (const float*)(ws + WS_MOD), p.out, (float*)(ws + WS_PART), ks};
        pg8::gemm_phase((LAS unsigned char*)smem, g, S, E);
    }
}

DEVI void phase7(const Params& p) {
    unsigned char* ws = p.ws;
    const int tid = threadIdx.x, lane = tid & 63, w = tid >> 6;
    const float* mod = (const float*)(ws + WS_MOD);
    bf16_t* u2 = (bf16_t*)(ws + WS_BUFB);
    const int nw = gridDim.x * 8;
    for (int tok0 = blockIdx.x * 8 + w; tok0 < NT; tok0 += 2 * nw) {
        float v[2][16];
        const bool has2 = tok0 + nw < NT;
#pragma unroll
        for (int t = 0; t < 2; ++t) {
            const int tok = (t == 0 || has2) ? tok0 + t * nw : tok0;
            const float* x = p.out + (size_t)tok * D;
#pragma unroll
            for (int i = 0; i < 4; ++i) { const float4 q4 = *(const float4*)(x + i * 256 + lane * 4); v[t][i * 4] = q4.x; v[t][i * 4 + 1] = q4.y; v[t][i * 4 + 2] = q4.z; v[t][i * 4 + 3] = q4.w; }
            if (tok >= NTP) {
                const float* pp = (const float*)(ws + WS_PART) + (size_t)(tok - NTP) * D;
#pragma unroll
                for (int k = 0; k < 3; ++k)
#pragma unroll
                    for (int i = 0; i < 4; ++i) { const float4 q4 = *(const float4*)(pp + (size_t)k * NTS * D + i * 256 + lane * 4); v[t][i * 4] += q4.x; v[t][i * 4 + 1] += q4.y; v[t][i * 4 + 2] += q4.z; v[t][i * 4 + 3] += q4.w; }
            }
        }
#pragma unroll
        for (int t = 0; t < 2; ++t) {
            if (t == 1 && !has2) break;
            const int tok = tok0 + t * nw;
            float* x = p.out + (size_t)tok * D;
            const float* ms = mod + (size_t)seq_of(tok) * NMOD;
            float s = 0.f;
#pragma unroll
            for (int i = 0; i < 16; ++i) s += v[t][i];
            float mean = wave_sum(s) * (1.f / 1024.f);
            float q = 0.f;
#pragma unroll
            for (int i = 0; i < 16; ++i) { v[t][i] -= mean; q += v[t][i] * v[t][i]; }
            float rstd = rsqrtf(wave_sum(q) * (1.f / 1024.f) + LN_EPS);
            s = 0.f;
#pragma unroll
            for (int i = 0; i < 4; ++i) {
                const int c = i * 256 + lane * 4;
                const float4 g = *(const float4*)(p.ln1_g + c), bq = *(const float4*)(p.ln1_b + c);
                v[t][i * 4] = v[t][i * 4] * rstd * g.x + bq.x; v[t][i * 4 + 1] = v[t][i * 4 + 1] * rstd * g.y + bq.y;
                v[t][i * 4 + 2] = v[t][i * 4 + 2] * rstd * g.z + bq.z; v[t][i * 4 + 3] = v[t][i * 4 + 3] * rstd * g.w + bq.w;
                *(float4*)(x + c) = float4{v[t][i * 4], v[t][i * 4 + 1], v[t][i * 4 + 2], v[t][i * 4 + 3]};
                s += v[t][i * 4] + v[t][i * 4 + 1] + v[t][i * 4 + 2] + v[t][i * 4 + 3];
            }
            mean = wave_sum(s) * (1.f / 1024.f);
            q = 0.f;
#pragma unroll
            for (int i = 0; i < 16; ++i) { v[t][i] -= mean; q += v[t][i] * v[t][i]; }
            rstd = rsqrtf(wave_sum(q) * (1.f / 1024.f) + LN_EPS);
#pragma unroll
            for (int i = 0; i < 4; ++i) {
                const int c = i * 256 + lane * 4;
                const float4 sh = *(const float4*)(ms + 3072 + c), sc = *(const float4*)(ms + 4096 + c);
                *(uint2*)(u2 + (size_t)tok * D + c) = uint2{pack2(v[t][i * 4] * rstd * (1.f + sc.x) + sh.x, v[t][i * 4 + 1] * rstd * (1.f + sc.y) + sh.y),
                                                            pack2(v[t][i * 4 + 2] * rstd * (1.f + sc.z) + sh.z, v[t][i * 4 + 3] * rstd * (1.f + sc.w) + sh.w)};
            }
        }
    }
}

DEVI void combine_pair(const int* k0, const int* k1, int* ed, float* gd) {
        int ka[16], kb[16];
#pragma unroll
        for (int i = 0; i < 4; ++i) {
            const int4 a = *(const int4*)(k0 + i * 4), b = *(const int4*)(k1 + i * 4);
            ka[i * 4] = a.x; ka[i * 4 + 1] = a.y; ka[i * 4 + 2] = a.z; ka[i * 4 + 3] = a.w;
            kb[i * 4] = b.x; kb[i * 4 + 1] = b.y; kb[i * 4 + 2] = b.z; kb[i * 4 + 3] = b.w;
        }
        float va[16], vb[16];
#pragma unroll
        for (int i = 0; i < 16; ++i) { va[i] = key_val(ka[i], 0x7F); vb[i] = key_val(kb[i], 0x7F); }
        int R[16];
#define CAND(i, j) key_enc(va[i] + vb[j], ((i) << 4) | (j), 0xFF)
        {
            int N0[16] = {CAND(0,0), CAND(0,1), CAND(0,2), CAND(0,3), CAND(0,4), CAND(0,5), CAND(0,6), CAND(0,7), CAND(0,8), CAND(0,9), CAND(0,10), CAND(0,11), CAND(0,12), CAND(0,13), CAND(0,14), CAND(0,15)};
            bitonic_sort_desc<16>(N0);
#pragma unroll
            for (int i = 0; i < 16; ++i) R[i] = N0[i];
        }
        {
            int N1[16] = {CAND(1,0), CAND(1,1), CAND(1,2), CAND(1,3), CAND(1,4), CAND(1,5), CAND(1,6), CAND(1,7), CAND(2,0), CAND(2,1), CAND(2,2), CAND(2,3), CAND(2,4), CAND(3,0), CAND(3,1), CAND(3,2)};
            bitonic_sort_desc<16>(N1);
#pragma unroll
            for (int i = 0; i < 16; ++i) R[i] = max(R[i], N1[15 - i]);
            bitonic_merge16_desc(R);
        }
        {
            int N2[16] = {CAND(3,3), CAND(4,0), CAND(4,1), CAND(4,2), CAND(5,0), CAND(5,1), CAND(6,0), CAND(6,1), CAND(7,0), CAND(7,1), CAND(8,0), CAND(9,0), CAND(10,0), CAND(11,0), CAND(12,0), CAND(13,0)};
            bitonic_sort_desc<16>(N2);
#pragma unroll
            for (int i = 0; i < 16; ++i) R[i] = max(R[i], N2[15 - i]);
            bitonic_merge16_desc(R);
        }
        {
            int N3[16];
            N3[0] = max(CAND(14,0), CAND(15,0)); N3[1] = min(CAND(14,0), CAND(15,0));
#pragma unroll
            for (int i = 2; i < 16; ++i) N3[i] = (int)0x80000000;
#pragma unroll
            for (int i = 0; i < 16; ++i) R[i] = max(R[i], N3[15 - i]);
            bitonic_merge16_desc(R);
        }
#undef CAND
        float val[16]; int ex[16];
#pragma unroll
        for (int k = 0; k < 16; ++k) {
            const int i = (R[k] >> 4) & 15, j = R[k] & 15;
            const int a = k0[i], b = k1[j];
            val[k] = key_val(a, 0x7F) + key_val(b, 0x7F);
            ex[k] = (a & 0x7F) * 128 + (b & 0x7F);
        }
        float mx = val[0];
#pragma unroll
        for (int k = 1; k < 16; ++k) mx = fmaxf(mx, val[k]);
        float sum = 0.f;
#pragma unroll
        for (int k = 0; k < 16; ++k) { val[k] = expf(val[k] - mx); sum += val[k]; }
        const float inv = 1.f / sum;
#pragma unroll
        for (int k = 0; k < 16; k += 4) {
            *(int4*)(ed + k) = int4{ex[k], ex[k + 1], ex[k + 2], ex[k + 3]};
            *(float4*)(gd + k) = float4{val[k] * inv, val[k + 1] * inv, val[k + 2] * inv, val[k + 3] * inv};
        }
}

DEVI void phase8a(const Params& p, unsigned char* smem) {
    unsigned char* ws = p.ws;
    pg8::Gemm g{(const bf16_t*)(ws + WS_BUFB), (const bf16_t*)(ws + WS_WTQ), NT, 2048, D, D};
    pg8::StaticOrder S; S.init(NT, 2048, (int)gridDim.x, (int)blockIdx.x);
    EpiQ E{(bf16_t*)(ws + WS_Q)};
    pg8::gemm_phase((LAS unsigned char*)smem, g, S, E);
}

DEVI void phase8(const Params& p, unsigned char* smem_all) {
    unsigned char* smem = smem_all + VHALF * SMEM_HALF;
    unsigned char* ws = p.ws;
    const int tid = TID, lane = tid & 63, w = tid >> 6, wr = w >> 1, wc = w & 1, fr = lane & 15, fq = lane >> 4;
    const bf16_t* Q = (const bf16_t*)(ws + WS_Q);
    const int lr = tid >> 4, lkc = tid & 15;
    u32x4 qr[8];
    {
        const int item = (int)blockIdx.x * 2 + VHALF;
        if (item < 132 * 16) {
            const int mt = item >> 4, hp = item & 15;
#pragma unroll
            for (int i = 0; i < 8; ++i) {
                qr[i] = *(const u32x4*)(Q + (size_t)(mt * 128 + lr + 16 * i) * 2048 + hp * 128 + lkc * 8);
            }
        }
    }
    for (int it0 = blockIdx.x * 2; it0 < 132 * 16; it0 += NVB) {
        const int item = it0 + VHALF;
        const int mt = item >> 4, hp = item & 15;
        f32x4 acc[4][4];
        bf16_t* Qs = (bf16_t*)smem;
        bf16_t* Kb = (bf16_t*)(smem + 128 * LDW * 2);
#pragma unroll
        for (int i = 0; i < 8; ++i) {
            *(u32x4*)&Qs[(lr + 16 * i) * LDW + lkc * 8] = qr[i];
            *(u32x4*)&Kb[(lr + 16 * i) * LDW + lkc * 8] = *(const u32x4*)((const bf16_t*)(ws + WS_KEYS) + hp * 16384 + (lr + 16 * i) * 128 + lkc * 8);
        }
        LDS_BAR();
        mma_lds128(Qs, Kb, acc);
        LDS_BAR();
        float* Sc = (float*)smem;
#pragma unroll
        for (int m = 0; m < 4; ++m)
#pragma unroll
            for (int n = 0; n < 4; ++n) {
                float* d = &Sc[(wr * 64 + m * 16 + fr) * 130 + wc * 64 + n * 16 + fq * 4];
                d[0] = acc[m][n][0]; d[1] = acc[m][n][1]; d[2] = acc[m][n][2]; d[3] = acc[m][n][3];
            }
        if (it0 + NVB < 132 * 16) {
            const int itn = it0 + NVB + VHALF, mtn = itn >> 4, hpn = itn & 15;
#pragma unroll
            for (int i = 0; i < 8; ++i) {
                qr[i] = *(const u32x4*)(Q + (size_t)(mtn * 128 + lr + 16 * i) * 2048 + hpn * 128 + lkc * 8);
            }
        }
        LDS_BAR();
        {
            const int row = tid >> 1, half = tid & 1;
            const float* sr = &Sc[row * 130 + half];
            int R[16];
#pragma unroll
            for (int g = 0; g < 4; ++g) {
                int Nn[16];
#pragma unroll
                for (int i = 0; i < 16; ++i) { const int idx = 2 * (g * 16 + i) + half; Nn[i] = key_enc(sr[2 * (g * 16 + i)], idx, 0x7F); }
                bitonic_sort_desc<16>(Nn);
                if (g == 0) {
#pragma unroll
                    for (int i = 0; i < 16; ++i) R[i] = Nn[i];
                } else {
#pragma unroll
                    for (int i = 0; i < 16; ++i) R[i] = max(R[i], Nn[15 - i]);
                    bitonic_merge16_desc(R);
                }
            }
            int T[16];
#pragma unroll
            for (int i = 0; i < 16; ++i) T[i] = __shfl_xor(R[15 - i], 1);
#pragma unroll
            for (int i = 0; i < 16; ++i) R[i] = max(R[i], T[i]);
            bitonic_merge16_desc(R);
            LDS_BAR();
            if (half == 0) {
                int* dst = (int*)smem + row * 16;
                *(int4*)dst = int4{R[0], R[1], R[2], R[3]}; *(int4*)(dst + 4) = int4{R[4], R[5], R[6], R[7]};
                *(int4*)(dst + 8) = int4{R[8], R[9], R[10], R[11]}; *(int4*)(dst + 12) = int4{R[12], R[13], R[14], R[15]};
            }
        }
        LDS_BAR();
        if (threadIdx.x < 128) {
            const int tok = mt * 128 + (int)threadIdx.x, hh = hp >> 1;
            combine_pair((const int*)smem_all + threadIdx.x * 16, (const int*)(smem_all + SMEM_HALF) + threadIdx.x * 16,
                         (int*)(ws + WS_EG) + (size_t)tok * 128 + hh * 16, (float*)(ws + WS_GG) + (size_t)tok * 128 + hh * 16);
        }
        LDS_BAR();
    }
}

DEVI float dpp_sum_to_lane63(float v) {
    v += __builtin_bit_cast(float, __builtin_amdgcn_update_dpp(0, __builtin_bit_cast(int, v), 0x111, 0xf, 0xf, true));
    v += __builtin_bit_cast(float, __builtin_amdgcn_update_dpp(0, __builtin_bit_cast(int, v), 0x112, 0xf, 0xf, true));
    v += __builtin_bit_cast(float, __builtin_amdgcn_update_dpp(0, __builtin_bit_cast(int, v), 0x114, 0xf, 0xf, true));
    v += __builtin_bit_cast(float, __builtin_amdgcn_update_dpp(0, __builtin_bit_cast(int, v), 0x118, 0xf, 0xf, true));
    v += __builtin_bit_cast(float, __builtin_amdgcn_update_dpp(0, __builtin_bit_cast(int, v), 0x142, 0xa, 0xf, false));
    v += __builtin_bit_cast(float, __builtin_amdgcn_update_dpp(0, __builtin_bit_cast(int, v), 0x143, 0xc, 0xf, false));
    return v;
}
DEVI float dpp_sum_half(float v) {
    v += __builtin_bit_cast(float, __builtin_amdgcn_update_dpp(0, __builtin_bit_cast(int, v), 0x111, 0xf, 0xf, true));
    v += __builtin_bit_cast(float, __builtin_amdgcn_update_dpp(0, __builtin_bit_cast(int, v), 0x112, 0xf, 0xf, true));
    v += __builtin_bit_cast(float, __builtin_amdgcn_update_dpp(0, __builtin_bit_cast(int, v), 0x114, 0xf, 0xf, true));
    v += __builtin_bit_cast(float, __builtin_amdgcn_update_dpp(0, __builtin_bit_cast(int, v), 0x118, 0xf, 0xf, true));
    v += __builtin_bit_cast(float, __builtin_amdgcn_update_dpp(0, __builtin_bit_cast(int, v), 0x142, 0xa, 0xf, false));
    return v;
}
DEVI float rdlane(float v, int l) { return __builtin_bit_cast(float, __builtin_amdgcn_readlane(__builtin_bit_cast(int, v), l)); }
DEVI int rdlanei(int v, int l) { return __builtin_amdgcn_readlane(v, l); }

DEVI void phase10(const Params& p, unsigned char* smem) {
    (void)smem;
    unsigned char* ws = p.ws;
    const int tid = threadIdx.x, lane = tid & 63, w = tid >> 6;
    const unsigned char* UT = ws + WS_UT;
    const unsigned char* VT = ws + WS_VT;
    const float* USC = (const float*)(ws + WS_USC);
    const float* VSC = (const float*)(ws + WS_VSC);
    const bf16_t* u2 = (const bf16_t*)(ws + WS_BUFB);
    const float* mod = (const float*)(ws + WS_MOD);
    unsigned* cnt = (unsigned*)(ws + WS_CTL) + CW_CNT;
    for (;;) {
        int tok = 0;
        if (lane == 0) tok = (int)atomicAdd(cnt, 1u);
        tok = __builtin_amdgcn_readfirstlane(tok);
        if (tok >= NT) break;
        const int* Eg = (const int*)(ws + WS_EG) + (size_t)tok * 128;
        const float* Gg = (const float*)(ws + WS_GG) + (size_t)tok * 128;
        const int ea = Eg[lane], eb = Eg[lane + 64];
        const float ga = Gg[lane], gb = Gg[lane + 64];
        const float sua = USC[ea], sub = USC[eb], sva = VSC[ea], svb = VSC[eb];
        const int hl = lane & 31, hi = lane >> 5;
        f32x2 uf[16];
        {
            const bf16_t* ur = u2 + (size_t)tok * D + hl * 32;
#pragma unroll
            for (int q = 0; q < 4; ++q) {
                const uint4 qv = *(const uint4*)(ur + q * 8);
                uf[q * 4 + 0] = f32x2{bf_lo(qv.x), bf_hi(qv.x)}; uf[q * 4 + 1] = f32x2{bf_lo(qv.y), bf_hi(qv.y)};
                uf[q * 4 + 2] = f32x2{bf_lo(qv.z), bf_hi(qv.z)}; uf[q * 4 + 3] = f32x2{bf_lo(qv.w), bf_hi(qv.w)};
            }
        }
        float act_a = 0.f, act_b = 0.f;
#pragma unroll
        for (int hb = 0; hb < 2; ++hb) {
            const int esel = hb ? eb : ea;
            float actv = 0.f;
            for (int jb = 0; jb < 64; jb += 32) {
                u32x4 x[16];
#pragma unroll
                for (int i = 0; i < 16; ++i) {
                    const int eA = rdlanei(esel, jb + i), eB = rdlanei(esel, jb + 16 + i);
                    const int e = hi ? eB : eA;
                    x[i] = *(const u32x4*)(UT + (size_t)e * 512 + hl * 16);
                }
#pragma unroll
                for (int i = 0; i < 16; ++i) {
                    f32x2 a2 = f32x2{0.f, 0.f};
#pragma unroll
                    for (int wq = 0; wq < 4; ++wq) {
                        a2 += __builtin_amdgcn_cvt_scalef32_pk_f32_fp4(x[i][wq], 1.0f, 0) * uf[wq * 4 + 0];
                        a2 += __builtin_amdgcn_cvt_scalef32_pk_f32_fp4(x[i][wq], 1.0f, 1) * uf[wq * 4 + 1];
                        a2 += __builtin_amdgcn_cvt_scalef32_pk_f32_fp4(x[i][wq], 1.0f, 2) * uf[wq * 4 + 2];
                        a2 += __builtin_amdgcn_cvt_scalef32_pk_f32_fp4(x[i][wq], 1.0f, 3) * uf[wq * 4 + 3];
                    }
                    const float hs = dpp_sum_half(a2.x + a2.y);
                    const float totA = rdlane(hs, 31), totB = rdlane(hs, 63);
                    actv = (lane == jb + i) ? totA : actv;
                    actv = (lane == jb + 16 + i) ? totB : actv;
                }
            }
            if (hb) act_b = actv; else act_a = actv;
        }
        const float cfa = ga * gelu_exact(act_a * sua) * sva;
        const float cfb = gb * gelu_exact(act_b * sub) * svb;
        f32x2 ya[16];
#pragma unroll
        for (int i = 0; i < 16; ++i) ya[i] = f32x2{0.f, 0.f};
#pragma unroll
        for (int hb = 0; hb < 2; ++hb) {
            const int esel = hb ? eb : ea;
            const float csel = hb ? cfb : cfa;
            for (int jb = 0; jb < 64; jb += 32) {
                u32x4 x[16];
#pragma unroll
                for (int i = 0; i < 16; ++i) {
                    const int eA = rdlanei(esel, jb + i), eB = rdlanei(esel, jb + 16 + i);
                    const int e = hi ? eB : eA;
                    x[i] = *(const u32x4*)(VT + (size_t)e * 512 + hl * 16);
                }
#pragma unroll
                for (int i = 0; i < 16; ++i) {
                    const float cA = rdlane(csel, jb + i), cB = rdlane(csel, jb + 16 + i);
                    const float cf = hi ? cB : cA;
                    const f32x2 c2 = f32x2{cf, cf};
#pragma unroll
                    for (int wq = 0; wq < 4; ++wq) {
                        ya[wq * 4 + 0] += c2 * __builtin_amdgcn_cvt_scalef32_pk_f32_fp4(x[i][wq], 1.0f, 0);
                        ya[wq * 4 + 1] += c2 * __builtin_amdgcn_cvt_scalef32_pk_f32_fp4(x[i][wq], 1.0f, 1);
                        ya[wq * 4 + 2] += c2 * __builtin_amdgcn_cvt_scalef32_pk_f32_fp4(x[i][wq], 1.0f, 2);
                        ya[wq * 4 + 3] += c2 * __builtin_amdgcn_cvt_scalef32_pk_f32_fp4(x[i][wq], 1.0f, 3);
                    }
                }
            }
        }
#pragma unroll
        for (int i = 0; i < 16; ++i) { ya[i].x += __shfl_xor(ya[i].x, 32); ya[i].y += __shfl_xor(ya[i].y, 32); }
        const int cbase = hl * 32 + hi * 16;
        float* xo = p.out + (size_t)tok * D + cbase;
        const float* g2 = mod + (size_t)seq_of(tok) * NMOD + 5120 + cbase;
        float r[16];
        float s1 = 0.f;
#pragma unroll
        for (int i = 0; i < 4; ++i) {
            const float4 xv = *(const float4*)(xo + i * 4), gv = *(const float4*)(g2 + i * 4);
            const f32x2 y0 = hi ? ya[8 + i * 2] : ya[i * 2], y1 = hi ? ya[8 + i * 2 + 1] : ya[i * 2 + 1];
            r[i * 4 + 0] = ALPHA * xv.x + (1.f + gv.x) * y0.x; r[i * 4 + 1] = ALPHA * xv.y + (1.f + gv.y) * y0.y;
            r[i * 4 + 2] = ALPHA * xv.z + (1.f + gv.z) * y1.x; r[i * 4 + 3] = ALPHA * xv.w + (1.f + gv.w) * y1.y;
            s1 += r[i * 4] + r[i * 4 + 1] + r[i * 4 + 2] + r[i * 4 + 3];
        }
        const float mean = wave_sum(s1) * (1.f / 1024.f);
        float s2 = 0.f;
#pragma unroll
        for (int i = 0; i < 16; ++i) { r[i] -= mean; s2 += r[i] * r[i]; }
        const float rstd = rsqrtf(wave_sum(s2) * (1.f / 1024.f) + LN_EPS);
#pragma unroll
        for (int i = 0; i < 4; ++i) {
            const float4 la = *(const float4*)(p.ln2_g + cbase + i * 4), ba = *(const float4*)(p.ln2_b + cbase + i * 4);
            *(float4*)(xo + i * 4) = float4{r[i * 4] * rstd * la.x + ba.x, r[i * 4 + 1] * rstd * la.y + ba.y, r[i * 4 + 2] * rstd * la.z + ba.z, r[i * 4 + 3] * rstd * la.w + ba.w};
        }
    }
}

__global__ void __launch_bounds__(512, 2) mk_fwd(Params p, int ph_lo, int ph_hi, int use_cg) {
    extern __shared__ __attribute__((aligned(16))) unsigned char smem[];
    volatile LAS unsigned* xbw = (volatile LAS unsigned*)((LAS unsigned char*)smem + SMEM_BYTES);
    XcdBarrier bar; bar.bar = (unsigned*)(p.ws + WS_CTL) + CW_BAR; bar.x = 0; bar.st = xbw;
    if (ph_hi - ph_lo > 1 && !use_cg) {
        if (threadIdx.x < 4) xbw[threadIdx.x] = 0u;
        __syncthreads();
        bar = xcd_barrier_post((unsigned*)(p.ws + WS_CTL) + CW_BAR, xbw);
    }
#define SEAM(k) do { if (ph_lo <= (k) && (k) + 1 < ph_hi) { if (use_cg) cg::this_grid().sync(); else xcd_barrier(bar); } } while (0)
#define RUN(k) (ph_lo <= (k) && (k) < ph_hi)
    if (RUN(0)) phase0(p, smem);
    SEAM(0);
    if (RUN(1)) phase1(p, smem);
    SEAM(1);
    if (RUN(2)) phase2(p, smem);
    SEAM(2);
#ifndef REPA
#define REPA 1
#endif
#ifndef REPB
#define REPB 1
#endif
#ifndef REPC
#define REPC 1
#endif
#ifndef REPD
#define REPD 1
#endif
    if (RUN(3)) for (int r = 0; r < REPA; ++r) { phase3(p, smem); if (r + 1 < REPA) xcd_barrier(bar); }
    SEAM(3);
    if (RUN(4)) for (int r = 0; r < REPB; ++r) { phase4(p, smem); if (r + 1 < REPB) xcd_barrier(bar); }
    SEAM(4);
    if (RUN(5)) phase5(p, smem);
    SEAM(5);
    if (RUN(6)) phase6(p, smem);
    SEAM(6);
    if (RUN(7)) phase7(p);
    SEAM(7);
    if (RUN(8)) for (int r = 0; r < REPC; ++r) { phase8a(p, smem); if (r + 1 < REPC) xcd_barrier(bar); }
    SEAM(8);
    if (RUN(9)) for (int r = 0; r < REPD; ++r) { phase8(p, smem); if (r + 1 < REPD) xcd_barrier(bar); }
    SEAM(9);
    if (RUN(10)) phase10(p, smem);
}

extern "C" void kernel_launch(void* const* d_in, const int* in_sizes, int n_in, void* d_out, int out_size, void* d_ws, size_t ws_size, hipStream_t stream) {
    static int grid = 0;
    if (grid == 0) {
        int dev = 0, cus = 0, per_cu = 0;
        (void)hipGetDevice(&dev);
        (void)hipDeviceGetAttribute(&cus, hipDeviceAttributeMultiprocessorCount, dev);
        (void)hipFuncSetAttribute((const void*)mk_fwd, hipFuncAttributeMaxDynamicSharedMemorySize, LDS_DYN);
        (void)hipOccupancyMaxActiveBlocksPerMultiprocessor(&per_cu, (const void*)mk_fwd, 512, LDS_DYN);
        if (per_cu < 1) fprintf(stderr, "kernel_launch: occupancy query says %d workgroups per CU\n", per_cu);
        grid = cus;
        if (ws_size < WS_END) fprintf(stderr, "kernel_launch: workspace too small: %zu < %zu\n", ws_size, (size_t)WS_END);
    }
    Params p{};
    const float** f = (const float**)&p;
    for (int i = 0; i < 24; ++i) f[i] = (const float*)d_in[i];
    p.out = (float*)d_out; p.ws = (unsigned char*)d_ws;
    (void)hipMemsetAsync((unsigned char*)d_ws + WS_CTL, 0, 65536, stream);
    int lo = 0, hi = NPH, ucg = 0;
    void* args[] = {&p, &lo, &hi, &ucg};
    hipError_t e = hipLaunchCooperativeKernel((const void*)mk_fwd, dim3(grid), dim3(512), args, LDS_DYN, stream);
    if (e != hipSuccess) fprintf(stderr, "cooperative launch failed: %s (grid %d)\n", hipGetErrorString(e), grid);
}
#ifdef TEST4
__global__ void __launch_bounds__(512, 2) t4(Params p) { extern __shared__ __attribute__((aligned(16))) unsigned char sm4[]; phase4(p, sm4); }
__global__ void __launch_bounds__(512, 2) t4s(Params p) { extern __shared__ __attribute__((aligned(16))) unsigned char sm4[]; p4_state_scan(p, sm4 + VHALF * SMEM_HALF, blockIdx.x * 2 + VHALF); }
__global__ void __launch_bounds__(512, 2) t3(Params p) { extern __shared__ __attribute__((aligned(16))) unsigned char sm4[]; phase3(p, sm4); }
__global__ void __launch_bounds__(512, 2) t6(Params p) { extern __shared__ __attribute__((aligned(16))) unsigned char sm4[]; phase6(p, sm4); }
#endif
```

```cpp
#include <hip/hip_runtime.h>
#include <hip/hip_cooperative_groups.h>
#include <cstdio>
#include <cstdint>
namespace cg = cooperative_groups;


#ifndef UFP4
#define UFP4 1
#endif
#ifndef FUSED
#define FUSED 1
#endif

#define DEVI __device__ __forceinline__
#define TID ((int)(threadIdx.x & 255u))
#define VHALF ((int)(threadIdx.x >> 8))
#define NVB ((int)gridDim.x * 2)
#define LAS __attribute__((address_space(3)))

typedef unsigned short bf16_t;
typedef short bf16x8 __attribute__((ext_vector_type(8)));
typedef short s16x4 __attribute__((ext_vector_type(4)));
typedef float f32x4 __attribute__((ext_vector_type(4)));
typedef unsigned u32x4 __attribute__((ext_vector_type(4)));
typedef __bf16 bf2_t __attribute__((ext_vector_type(2)));

constexpr int D = 1024, NTP = 16384, NTS = 512, NT = NTP + NTS, SEQ = 2048, NSEQ = 136;
constexpr int DIN = 2568, NP = 2560, NMOD = 6144;
constexpr int NPH = 11;
constexpr float ALPHA = 1.189207115002721f;
constexpr float LN_EPS = 1e-5f;
constexpr float KSCALE = 0.08838834764831845f;

constexpr size_t O_Y = 0, O_POOLP = 17301504, O_CP = 17362944, O_NP = 17887232, O_MP = 17891328,
                 O_POOLS = 17891360, O_CS = 18874400, O_NS = 27263008, O_MS = 27328544;

constexpr size_t WS_CTL = 0;
constexpr size_t WS_MOD = 65536;
constexpr size_t WS_GATES = WS_MOD + 6291456;
constexpr size_t WS_MST = WS_GATES + 540672;
constexpr size_t WS_NST = WS_MST + 8192;
constexpr size_t WS_WTIN = WS_NST + 524288;
constexpr size_t WS_WTOUT = WS_WTIN + 5242880;
constexpr size_t WS_WTQ = WS_WTOUT + 2097152;
constexpr size_t WS_WTMOD = WS_WTQ + 4194304;
constexpr size_t WS_GA = WS_WTMOD;
constexpr size_t WS_BB = WS_GA + 262144;
constexpr size_t WS_RR = WS_BB + 262144;
constexpr size_t WS_RPM = WS_RR + 262144;
constexpr size_t WS_BCH = WS_RPM + 262144;
constexpr size_t WS_WTPOOL = WS_WTMOD + 12582912;
constexpr size_t WS_KEYS = WS_WTPOOL + 131072;
constexpr size_t WS_AMOD = WS_KEYS + 524288;
constexpr size_t WS_UT = WS_AMOD + 524288;
constexpr size_t WS_USC = WS_UT + 16777216;
constexpr size_t WS_VT = WS_UT + 33554432;
constexpr size_t WS_VSC = WS_VT + 16777216;
constexpr size_t WS_BUFA = WS_VT + 33554432;
constexpr size_t WS_BUFB = WS_BUFA + 34603008;
constexpr size_t WS_P = WS_BUFB + 34603008;
constexpr size_t WS_PART = WS_P;
constexpr size_t WS_Q = WS_P;
constexpr size_t WS_K16 = WS_P + 69206016;
constexpr size_t WS_EG = WS_BUFA;
constexpr size_t WS_GG = WS_EG + 8650752;
constexpr size_t WS_END = WS_P + 86507520;

constexpr int CW_BAR = 0;
constexpr int CW_CNT = 4096;

struct Params {
    const float *x_prompt, *x_sample, *c_prompt, *c_sample, *state_pool, *state_C, *state_n, *state_m;
    const float *w_mod, *b_mod, *w_in, *b_in, *w_pool, *pool_scale, *mh_norm_g, *w_out, *ln1_g, *ln1_b;
    const float *w_q, *sub_keys, *u_tab, *v_tab, *ln2_g, *ln2_b;
    float* out;
    unsigned char* ws;
};

typedef float f32x2 __attribute__((ext_vector_type(2)));
DEVI unsigned pack2(float lo, float hi) { const f32x2 v = {lo, hi}; const bf2_t b = __builtin_convertvector(v, bf2_t); return __builtin_bit_cast(unsigned, b); }
DEVI float dot2bf(unsigned a, unsigned b, float c) { return __builtin_amdgcn_fdot2_f32_bf16(__builtin_bit_cast(bf2_t, a), __builtin_bit_cast(bf2_t, b), c, false); }
DEVI float bf_lo(unsigned u) { return __uint_as_float(u << 16); }
DEVI float bf_hi(unsigned u) { return __uint_as_float(u & 0xFFFF0000u); }
DEVI float bf1(bf16_t h) { return __uint_as_float(((unsigned)h) << 16); }
DEVI float wave_sum(float v) {
#pragma unroll
    for (int o = 32; o > 0; o >>= 1) v += __shfl_xor(v, o);
    return v;
}
DEVI float sum16(float v) {
#pragma unroll
    for (int o = 8; o > 0; o >>= 1) v += __shfl_xor(v, o);
    return v;
}
DEVI float sumq(float v) {
    v += __shfl_xor(v, 16); v += __shfl_xor(v, 32); return v;
}
DEVI float logsigmoid(float x) { return fminf(x, 0.f) - log1pf(expf(-fabsf(x))); }
DEVI float sigmoidf_(float x) { return 1.f / (1.f + expf(-x)); }
DEVI float gelu_exact(float x) { return 0.5f * x * (1.f + erff(x * 0.7071067811865476f)); }
DEVI float scan_sum_incl(float v, int lane) {
#pragma unroll
    for (int o = 1; o < 64; o <<= 1) { float t = __shfl_up(v, o); if (lane >= o) v += t; }
    return v;
}
DEVI float scan_max_incl(float v, int lane) {
#pragma unroll
    for (int o = 1; o < 64; o <<= 1) { float t = __shfl_up(v, o); if (lane >= o) v = fmaxf(v, t); }
    return v;
}
DEVI const float* xrow_ptr(const Params& p, int tok) { return tok < NTP ? p.x_prompt + (size_t)tok * D : p.x_sample + (size_t)(tok - NTP) * D; }
DEVI int seq_of(int tok) { return tok < NTP ? (tok >> 11) : 8 + ((tok - NTP) >> 2); }

DEVI int key_enc(float f, int payload, int mask) { int b = __float_as_int(f); int k = b ^ ((b >> 31) & 0x7FFFFFFF); return (k & ~mask) | payload; }
DEVI float key_val(int k, int mask) { int k2 = k & ~mask; return __int_as_float(k2 ^ ((k2 >> 31) & 0x7FFFFFFF)); }

template <int N> DEVI void bitonic_sort_desc(int (&a)[N]) {
#pragma unroll
    for (int k = 2; k <= N; k <<= 1) {
#pragma unroll
        for (int j = k >> 1; j > 0; j >>= 1) {
#pragma unroll
            for (int i = 0; i < N; ++i) {
                const int l = i ^ j;
                if (l > i) {
                    const bool desc = ((i & k) == 0);
                    const int mx = max(a[i], a[l]), mn = min(a[i], a[l]);
                    a[i] = desc ? mx : mn; a[l] = desc ? mn : mx;
                }
            }
        }
    }
}
DEVI void bitonic_merge16_desc(int (&a)[16]) {
#pragma unroll
    for (int j = 8; j > 0; j >>= 1) {
#pragma unroll
        for (int i = 0; i < 16; ++i) {
            const int l = i ^ j;
            if (l > i) { const int mx = max(a[i], a[l]), mn = min(a[i], a[l]); a[i] = mx; a[l] = mn; }
        }
    }
}

#define XB_TMO      128
#define XB_XCNT(j)  (256  + 64 * (j))
#define XB_XSUB(j)  (1280 + 64 * (j))
#define XB_XGEN(j)  (2304 + 64 * (j))
#define XB_TOP      3328
#define XB_TOPGEN   3392
#define XCD_BAR_WORDS 3456
#define XB_SPIN_CAP (1u << 22)
DEVI unsigned xb_ld(unsigned* p) { return __hip_atomic_load(p, __ATOMIC_RELAXED, __HIP_MEMORY_SCOPE_AGENT); }
DEVI unsigned xb_add(unsigned* p, unsigned v) { return __hip_atomic_fetch_add(p, v, __ATOMIC_RELAXED, __HIP_MEMORY_SCOPE_AGENT); }
DEVI unsigned xb_xcc_id() { return (unsigned)__builtin_amdgcn_s_getreg((3 << 11) | 20) & 0xFu; }
#define XB_SPIN(cond, bar) do { unsigned _sp = 0; while (cond) { __builtin_amdgcn_s_sleep(1); \
    if ((++_sp & 255u) == 0u) { if (xb_ld(&(bar)[XB_TMO])) break; if (_sp > XB_SPIN_CAP) { atomicAdd(&(bar)[XB_TMO], 1u); break; } } } } while (0)
struct XcdBarrier { unsigned* bar; unsigned x; volatile LAS unsigned* st; };
DEVI XcdBarrier xcd_barrier_post(unsigned* bar, volatile LAS unsigned* st) {
    XcdBarrier b; b.bar = bar; b.x = xb_xcc_id(); b.st = st;
    if (threadIdx.x == 0) (void)xb_add(&bar[XB_XCNT(b.x)], 1u);
    return b;
}
DEVI void xcd_barrier_complete(unsigned* bar, unsigned x, unsigned& nloc, unsigned& nx) {
    const unsigned G = gridDim.x * gridDim.y * gridDim.z;
    unsigned sum, cnt, mine, sp = 0u;
    for (;;) {
        sum = 0u; cnt = 0u; mine = 0u;
#pragma unroll
        for (unsigned j = 0; j < 16; ++j) { const unsigned c = xb_ld(&bar[XB_XCNT(j)]); sum += c; cnt += (c > 0u) ? 1u : 0u; mine = (j == x) ? c : mine; }
        if (sum == G) break;
        __builtin_amdgcn_s_sleep(1);
        if ((++sp & 255u) == 0u) { if (xb_ld(&bar[XB_TMO])) break; if (sp > XB_SPIN_CAP) { atomicAdd(&bar[XB_TMO], 1u); break; } }
    }
    nloc = mine > 0u ? mine : 1u; nx = cnt > 0u ? cnt : 1u;
}
DEVI void xcd_barrier(const XcdBarrier& b) {
    asm volatile("s_waitcnt vmcnt(0)" ::: "memory");
    __syncthreads();
    if (threadIdx.x == 0) {
        unsigned* bar = b.bar;
        __builtin_amdgcn_s_waitcnt(0);
        unsigned nloc = b.st[0], nx = b.st[1];
        if (nloc == 0u) { xcd_barrier_complete(bar, b.x, nloc, nx); b.st[0] = nloc; b.st[1] = nx; }
        const unsigned old = xb_add(&bar[XB_XSUB(b.x)], 1u);
        const unsigned gen = old / nloc;
        if (old + 1u == (gen + 1u) * nloc) {
            __builtin_amdgcn_fence(__ATOMIC_RELEASE, "agent");
            asm volatile("s_waitcnt vmcnt(0)" ::: "memory");
            const unsigned og = xb_add(&bar[XB_TOP], 1u);
            const unsigned tg = og / nx;
            if (og + 1u == (tg + 1u) * nx) xb_add(&bar[XB_TOPGEN], 1u);
            else XB_SPIN(xb_ld(&bar[XB_TOPGEN]) == tg, bar);
            __builtin_amdgcn_fence(__ATOMIC_ACQUIRE, "agent");
            xb_add(&bar[XB_XGEN(b.x)], 1u);
            asm volatile("s_waitcnt vmcnt(0)" ::: "memory");
        } else {
            XB_SPIN(xb_ld(&bar[XB_XGEN(b.x)]) == gen, bar);
            __builtin_amdgcn_fence(__ATOMIC_ACQUIRE, "agent");
            asm volatile("s_waitcnt vmcnt(0)" ::: "memory");
        }
    }
    __syncthreads();
}

constexpr int SMEM_HALF = 73728;
constexpr int SMEM_BYTES = 2 * SMEM_HALF;
constexpr int LDS_DYN = SMEM_BYTES + 64;
constexpr int LDT = 72;
constexpr int LDW = 136;

DEVI void mma_lds128(const bf16_t* Al, const bf16_t* Bl, f32x4 (&acc)[4][4]) {
    const int tid = TID, lane = tid & 63, w = tid >> 6, wr = w >> 1, wc = w & 1, fr = lane & 15, fq = lane >> 4;
#pragma unroll
    for (int m = 0; m < 4; ++m)
#pragma unroll
        for (int n = 0; n < 4; ++n) acc[m][n] = f32x4{0.f, 0.f, 0.f, 0.f};
#pragma unroll
    for (int ks = 0; ks < 4; ++ks) {
        bf16x8 a[4], b[4];
#pragma unroll
        for (int m = 0; m < 4; ++m) a[m] = *(const bf16x8*)&Al[(wr * 64 + m * 16 + fr) * LDW + ks * 32 + fq * 8];
#pragma unroll
        for (int n = 0; n < 4; ++n) b[n] = *(const bf16x8*)&Bl[(wc * 64 + n * 16 + fr) * LDW + ks * 32 + fq * 8];
#pragma unroll
        for (int m = 0; m < 4; ++m)
#pragma unroll
            for (int n = 0; n < 4; ++n) acc[m][n] = __builtin_amdgcn_mfma_f32_16x16x32_bf16(b[n], a[m], acc[m][n], 0, 0, 0);
    }
}

DEVI bf16x8 tr_frag(const bf16_t* base, int ld, int row0, int col0, int lane) {
    const int g = lane >> 4, li = lane & 15, q = li >> 2, pp = li & 3;
    const bf16_t* a0 = base + (row0 + g * 8 + q) * ld + col0 + pp * 4;
    s16x4 lo = __builtin_amdgcn_ds_read_tr16_b64_v4i16((LAS s16x4*)a0);
    s16x4 hi = __builtin_amdgcn_ds_read_tr16_b64_v4i16((LAS s16x4*)(a0 + 4 * ld));
    return bf16x8{lo[0], lo[1], lo[2], lo[3], hi[0], hi[1], hi[2], hi[3]};
}


namespace pg8 {
constexpr int BM = 256, BK = 64, HALF = 128, HTB = HALF * BK * 2, STAGE_BYTES = 8 * HTB, NXCD = 8, WGM = 8;
__host__ __device__ __forceinline__ int lds_byte(int r, int c) { const int st = (r >> 4) * 2 + (c >> 5), rr = r & 15, cc = c & 31, ob = rr * 64 + cc * 2; return st * 1024 + (ob ^ (((ob >> 9) & 1) << 5)); }
__host__ __device__ __forceinline__ void stage_rc(int b, int& R, int& C) { const int st = b / 1024, sb = b % 1024, swz = sb ^ (((sb >> 9) & 1) << 5); R = (st >> 1) * 16 + swz / 64; C = (st & 1) * 32 + (swz % 64) / 2; }
__host__ __device__ __forceinline__ int perm32(int rho) { const int n = rho >> 4, i = rho & 15; return 8 * (i >> 2) + 4 * n + (i & 3); }
struct Unit { int pm, pn; };
struct Gemm { const bf16_t* A; const bf16_t* Bt; int M, N, K, ld; };
struct StaticOrder {
    int nM, nN, nwg, G, c;
    __device__ void init(int M, int N, int G_, int c_) { nM = M / BM; nN = N / BM; nwg = nM * nN; G = G_; c = c_; }
    __device__ bool next(int i, Unit& u) const {
        const long L = (long)i * G + c; if (L >= nwg) return false;
        int wgid = (int)L; { const int q = nwg / NXCD, r = nwg % NXCD, xcd = wgid % NXCD, off = wgid / NXCD; wgid = (xcd < r ? xcd * (q + 1) : r * (q + 1) + (xcd - r) * q) + off; }
        const int nig = WGM * nN, gid = wgid / nig, fm = gid * WGM, gsz = (nM - fm) < WGM ? (nM - fm) : WGM;
        u.pm = fm + ((wgid % nig) % gsz); u.pn = (wgid % nig) / gsz; return true;
    }
};
struct OneUnit {
    bool has; Unit u;
    __device__ bool next(int i, Unit& o) const { if (i != 0 || !has) return false; o = u; return true; }
};
template <class Epi, class Order>
__device__ __forceinline__ void gemm_phase(LAS unsigned char* lds, const Gemm g, const Order& S, const Epi& E) {
    const int tid = threadIdx.x, wid = __builtin_amdgcn_readfirstlane(tid >> 6), lane = tid & 63, wr = wid >> 2, wc = wid & 3, fr = lane & 15, fq = lane >> 4;
    const int K = g.K, nt = K / BK, LD = g.ld;
    unsigned voffA[2], voffB[2];
#pragma unroll
    for (int i = 0; i < 2; ++i) { int R, C; stage_rc(tid * 16 + i * 8192, R, C); const int Rb = (R & ~31) + perm32(R & 31);
        voffA[i] = (unsigned)(R * LD + C) * 2u; voffB[i] = (unsigned)(Rb * LD + C) * 2u; }
    const size_t kstep = (size_t)(BK * 2);
    const size_t hstep = (size_t)HALF * LD * 2;
    const size_t tstep = 2 * hstep;
    const unsigned ldsw = (unsigned)wid * 1024u;
    const int aoff = lds_byte(wr * 64 + fr, fq * 8), boff = lds_byte(wc * 32 + fr, fq * 8);
#define PG8_SA(b, h) (((b) * 2 + (h)) * HTB)
#define PG8_SB(b, h) ((4 + (b) * 2 + (h)) * HTB)
#define PG8_STAGE(bufoff, gbase, voff) do { _Pragma("unroll") for (int _i = 0; _i < 2; ++_i) \
        __builtin_amdgcn_global_load_lds((const unsigned*)((const char*)(gbase) + (voff)[_i]), (LAS unsigned*)(lds + (bufoff) + ldsw + _i * 8192), 16, 0, 0); } while (0)
#define PG8_LDA(dst, b, h) do { _Pragma("unroll") for (int m = 0; m < 4; ++m) _Pragma("unroll") for (int k = 0; k < 2; ++k) dst[m][k] = *(const LAS bf16x8*)(lds + PG8_SA(b, h) + aoff + m * 2048 + k * 1024); } while (0)
#define PG8_LDB(dst, b, h) do { _Pragma("unroll") for (int n = 0; n < 2; ++n) _Pragma("unroll") for (int k = 0; k < 2; ++k) dst[n][k] = *(const LAS bf16x8*)(lds + PG8_SB(b, h) + boff + n * 2048 + k * 1024); } while (0)
#define PG8_MMA(ai, bj, At, Bt) do { __builtin_amdgcn_s_setprio(1); _Pragma("unroll") for (int m = 0; m < 4; ++m) _Pragma("unroll") for (int n = 0; n < 2; ++n) _Pragma("unroll") for (int k = 0; k < 2; ++k) \
        acc[ai][bj][m][n] = __builtin_amdgcn_mfma_f32_16x16x32_bf16(Bt[n][k], At[m][k], acc[ai][bj][m][n], 0, 0, 0); __builtin_amdgcn_s_setprio(0); } while (0)
#define PG8_WAIT_V(n) asm volatile("s_waitcnt vmcnt(" #n ")" ::: "memory")
#define PG8_WAIT_L(n) asm volatile("s_waitcnt lgkmcnt(" #n ")" ::: "memory")
#define PG8_BAR __builtin_amdgcn_s_barrier()
#define PG8_SCHED __builtin_amdgcn_sched_barrier(0)
    Unit cur, nxt; int ui = 0;
    if (!S.next(0, cur)) return;
    f32x4 acc[2][2][4][2];
#pragma unroll
    for (int a = 0; a < 2; ++a)
#pragma unroll
        for (int b = 0; b < 2; ++b)
#pragma unroll
            for (int m = 0; m < 4; ++m)
#pragma unroll
                for (int n = 0; n < 2; ++n) acc[a][b][m][n] = (f32x4){0.f, 0.f, 0.f, 0.f};
    bf16x8 At[4][2], B0[2][2], B1[2][2];
    const char* cA = (const char*)g.A + (size_t)cur.pm * tstep; const char* cB = (const char*)g.Bt + (size_t)cur.pn * tstep;
    PG8_STAGE(PG8_SB(0, 0), cB, voffB); PG8_STAGE(PG8_SB(0, 1), cB + hstep, voffB); PG8_STAGE(PG8_SA(0, 0), cA, voffA); PG8_STAGE(PG8_SA(0, 1), cA + hstep, voffA);
    if (wr == 1) PG8_BAR;
    PG8_WAIT_V(2); PG8_BAR;
    PG8_STAGE(PG8_SB(1, 0), cB + kstep, voffB); PG8_STAGE(PG8_SA(1, 0), cA + kstep, voffA); PG8_STAGE(PG8_SB(1, 1), cB + hstep + kstep, voffB);
    PG8_WAIT_V(6); PG8_BAR;
    for (;;) {
        const bool has_next = S.next(ui + 1, nxt);
        const char* nA = has_next ? (const char*)g.A + (size_t)nxt.pm * tstep : cA; const char* nB = has_next ? (const char*)g.Bt + (size_t)nxt.pn * tstep : cB;
        for (int t = 0; t < nt; t += 2) {
            const bool last = (t == nt - 2);
            const char* a1 = cA + (size_t)(t + 1) * kstep;
            const char* a2 = last ? nA : cA + (size_t)(t + 2) * kstep; const char* b2 = last ? nB : cB + (size_t)(t + 2) * kstep;
            const char* a3 = a2 + kstep; const char* b3 = b2 + kstep;
            PG8_LDB(B0, 0, 0); PG8_LDB(B1, 0, 1); PG8_SCHED; PG8_LDA(At, 0, 0); PG8_STAGE(PG8_SA(1, 1), a1 + hstep, voffA);
            PG8_WAIT_V(8); PG8_WAIT_L(0); PG8_BAR; PG8_MMA(0, 0, At, B0); PG8_MMA(0, 1, At, B1); PG8_BAR; PG8_SCHED;
            PG8_LDA(At, 0, 1); PG8_STAGE(PG8_SB(0, 0), b2, voffB); PG8_STAGE(PG8_SB(0, 1), b2 + hstep, voffB); PG8_STAGE(PG8_SA(0, 0), a2, voffA);
            PG8_WAIT_V(8); PG8_WAIT_L(0); PG8_BAR; PG8_MMA(1, 0, At, B0); PG8_MMA(1, 1, At, B1); PG8_BAR; PG8_SCHED;
            PG8_LDB(B0, 1, 0); PG8_LDB(B1, 1, 1); PG8_SCHED; PG8_LDA(At, 1, 0); PG8_STAGE(PG8_SA(0, 1), a2 + hstep, voffA);
            PG8_WAIT_V(8); PG8_WAIT_L(0); PG8_BAR; PG8_MMA(0, 0, At, B0); PG8_MMA(0, 1, At, B1); PG8_BAR; PG8_SCHED;
            PG8_LDA(At, 1, 1); PG8_STAGE(PG8_SB(1, 0), b3, voffB); PG8_STAGE(PG8_SB(1, 1), b3 + hstep, voffB); PG8_STAGE(PG8_SA(1, 0), a3, voffA);
            PG8_WAIT_V(8); PG8_WAIT_L(0); PG8_BAR; PG8_MMA(1, 0, At, B0); PG8_MMA(1, 1, At, B1); PG8_BAR; PG8_SCHED;
        }
        if (wr == 0) PG8_BAR;
        E(acc, cur, wr, wc, fr, fq);
        if (!has_next) break;
#pragma unroll
        for (int a = 0; a < 2; ++a)
#pragma unroll
            for (int b = 0; b < 2; ++b)
#pragma unroll
                for (int m = 0; m < 4; ++m)
#pragma unroll
                    for (int n = 0; n < 2; ++n) acc[a][b][m][n] = (f32x4){0.f, 0.f, 0.f, 0.f};
        cur = nxt; cA = nA; cB = nB; ++ui;
        if (wr == 1) PG8_BAR;
    }
    PG8_WAIT_V(0);
    PG8_BAR;
#undef PG8_SA
#undef PG8_SB
#undef PG8_STAGE
#undef PG8_LDA
#undef PG8_LDB
#undef PG8_MMA
#undef PG8_WAIT_V
#undef PG8_WAIT_L
#undef PG8_BAR
#undef PG8_SCHED
}
#define PG8_ROW(u, ai, m) ((u).pm * 256 + (ai) * 128 + wr * 64 + (m) * 16 + fr)
#define PG8_COL(u, bj, n) ((u).pn * 256 + (bj) * 128 + wc * 32 + fq * 8 + (n) * 4)
}

DEVI void transpose_tile(const float* __restrict__ src, int ld, bf16_t* __restrict__ dst, int K, int k0, int n0, float* tile) {
    const int tid = TID;
    const int n = tid & 63, kq = tid >> 6;
#pragma unroll 4
    for (int i = 0; i < 16; ++i) { const int k = kq * 16 + i; tile[k * 65 + n] = src[(size_t)(k0 + k) * ld + n0 + n]; }
    __syncthreads();
    const int kp = tid & 31, nq = tid >> 5;
#pragma unroll 4
    for (int i = 0; i < 8; ++i) {
        const int nn = nq * 8 + i;
        const float a = tile[(2 * kp) * 65 + nn], b = tile[(2 * kp + 1) * 65 + nn];
        *(unsigned*)&dst[(size_t)(n0 + nn) * K + k0 + 2 * kp] = pack2(a, b);
    }
    __syncthreads();
}

DEVI void phase0(const Params& p, unsigned char* smem) {
    float* tile = (float*)(smem + VHALF * SMEM_HALF);
    unsigned char* ws = p.ws;
    const int tid = TID;
    constexpr int T_IN = 640, T_OUT = 256, T_Q = 512, T_MOD = 1536, T_POOL = 16;
    constexpr int T_ALL = T_IN + T_OUT + T_Q + T_MOD + T_POOL;
    constexpr int L_KEYS = 128, L_AMOD = 128, L_POOL = 352;
    for (int it0 = blockIdx.x * 2; it0 < T_ALL; it0 += NVB) {
        int it = it0 + VHALF;
        if (it < T_IN) { transpose_tile(p.w_in, DIN, (bf16_t*)(ws + WS_WTIN), 1024, (it / 40) * 64, (it % 40) * 64, tile); continue; }
        it -= T_IN;
        if (it < T_OUT) { transpose_tile(p.w_out, 1024, (bf16_t*)(ws + WS_WTOUT), 1024, (it / 16) * 64, (it % 16) * 64, tile); continue; }
        it -= T_OUT;
        if (it < T_Q) { transpose_tile(p.w_q, 2048, (bf16_t*)(ws + WS_WTQ), 1024, (it / 32) * 64, (it % 32) * 64, tile); continue; }
        it -= T_Q;
        if (it < T_MOD) { transpose_tile(p.w_mod, NMOD, (bf16_t*)(ws + WS_WTMOD), 1024, (it / 96) * 64, (it % 96) * 64, tile); continue; }
        it -= T_MOD;
        { const int g = it >> 2, r = it & 3; transpose_tile(p.w_pool + g * 16384, 128, (bf16_t*)(ws + WS_WTPOOL) + g * 16384, 128, (r >> 1) * 64, (r & 1) * 64, tile); }
    }
    for (int item = blockIdx.x * 2 + VHALF; item < L_KEYS + L_AMOD + L_POOL; item += NVB) {
        int it = item;
        if (it < L_KEYS) {
            const size_t e = (size_t)it * 2048 + tid * 8;
            const float4 a = *(const float4*)(p.sub_keys + e), b = *(const float4*)(p.sub_keys + e + 4);
            *(uint4*)((bf16_t*)(ws + WS_KEYS) + e) = uint4{pack2(a.x, a.y), pack2(a.z, a.w), pack2(b.x, b.y), pack2(b.z, b.w)};
            continue;
        }
        it -= L_KEYS;
        if (it < L_AMOD) {
            const int row = it * 2 + (tid >> 7), col = (tid & 127) * 8;
            uint4 o = uint4{0u, 0u, 0u, 0u};
            if (row < NSEQ) {
                const float* c = (row < 8 ? p.c_prompt + (size_t)row * D : p.c_sample + (size_t)(row - 8) * D) + col;
                const float4 a = *(const float4*)c, b = *(const float4*)(c + 4);
                float v[8] = {a.x, a.y, a.z, a.w, b.x, b.y, b.z, b.w};
#pragma unroll
                for (int j = 0; j < 8; ++j) v[j] = v[j] * sigmoidf_(v[j]);
                o = uint4{pack2(v[0], v[1]), pack2(v[2], v[3]), pack2(v[4], v[5]), pack2(v[6], v[7])};
            }
            *(uint4*)((bf16_t*)(ws + WS_AMOD) + (size_t)row * D + col) = o;
            continue;
        }
        it -= L_AMOD;
        {
            const size_t e = (size_t)it * 2048 + tid * 8;
            const int b = (int)(e / (11 * 512)), r = (int)(e % (11 * 512));
            const float* sp = p.state_pool + (size_t)b * 15 * 512 + 4 * 512 + r;
            float* d = p.out + O_POOLS + (size_t)b * 15 * 512 + r;
            *(float4*)d = *(const float4*)sp; *(float4*)(d + 4) = *(const float4*)(sp + 4);
        }
    }
}

struct EpiMod {
    float* mod; const float* bias;
    DEVI void operator()(const f32x4 (&acc)[2][2][4][2], const pg8::Unit& u, int wr, int wc, int fr, int fq) const {
        f32x4 bv[2][2];
#pragma unroll
        for (int bj = 0; bj < 2; ++bj)
#pragma unroll
            for (int n = 0; n < 2; ++n) bv[bj][n] = *(const f32x4*)(bias + PG8_COL(u, bj, n));
#pragma unroll
        for (int ai = 0; ai < 2; ++ai)
#pragma unroll
            for (int m = 0; m < 4; ++m) {
                const int row = PG8_ROW(u, ai, m);
#pragma unroll
                for (int bj = 0; bj < 2; ++bj)
#pragma unroll
                    for (int n = 0; n < 2; ++n) *(f32x4*)(mod + (size_t)row * NMOD + PG8_COL(u, bj, n)) = acc[ai][bj][m][n] + bv[bj][n];
            }
    }
};
struct EpiP {
    bf16_t* P; const float* bias; float* out;
    DEVI void operator()(const f32x4 (&acc)[2][2][4][2], const pg8::Unit& u, int wr, int wc, int fr, int fq) const {
        f32x4 bv[2][2];
#pragma unroll
        for (int bj = 0; bj < 2; ++bj)
#pragma unroll
            for (int n = 0; n < 2; ++n) bv[bj][n] = *(const f32x4*)(bias + PG8_COL(u, bj, n));
#pragma unroll
        for (int ai = 0; ai < 2; ++ai)
#pragma unroll
            for (int m = 0; m < 4; ++m) {
                const int row = PG8_ROW(u, ai, m);
                float* pool_dst = nullptr;
                if (u.pn < 2) {
                    if (row < NTP) { const int t = row & (SEQ - 1); if (t >= SEQ - 15) pool_dst = out + O_POOLP + ((size_t)(row >> 11) * 15 + (t - (SEQ - 15))) * 512; }
                    else { const int r = row - NTP; pool_dst = out + O_POOLS + ((size_t)(r >> 2) * 15 + 11 + (r & 3)) * 512; }
                }
#pragma unroll
                for (int bj = 0; bj < 2; ++bj) {
                    const int col = PG8_COL(u, bj, 0);
                    const f32x4 v0 = acc[ai][bj][m][0] + bv[bj][0], v1 = acc[ai][bj][m][1] + bv[bj][1];
                    *(u32x4*)(P + (size_t)row * NP + col) = u32x4{pack2(v0[0], v0[1]), pack2(v0[2], v0[3]), pack2(v1[0], v1[1]), pack2(v1[2], v1[3])};
                    if (pool_dst) { *(f32x4*)(pool_dst + col) = v0; *(f32x4*)(pool_dst + col + 4) = v1; }
                }
            }
    }
};
struct EpiOut {
    const float* xp; const float* xs; const float* mod; float* out;
    DEVI void operator()(const f32x4 (&acc)[2][2][4][2], const pg8::Unit& u, int wr, int wc, int fr, int fq) const {
        const float* g1 = mod + (size_t)((u.pm * 256) >> 11) * NMOD + 2048;
        f32x4 gv[2][2];
#pragma unroll
        for (int bj = 0; bj < 2; ++bj)
#pragma unroll
            for (int n = 0; n < 2; ++n) gv[bj][n] = *(const f32x4*)(g1 + PG8_COL(u, bj, n)) + 1.f;
#pragma unroll
        for (int ai = 0; ai < 2; ++ai)
#pragma unroll
            for (int bj = 0; bj < 2; ++bj) {
                f32x4 xv[4][2];
#pragma unroll
                for (int m = 0; m < 4; ++m)
#pragma unroll
                    for (int n = 0; n < 2; ++n) xv[m][n] = *(const f32x4*)(xp + (size_t)PG8_ROW(u, ai, m) * D + PG8_COL(u, bj, n));
#pragma unroll
                for (int m = 0; m < 4; ++m)
#pragma unroll
                    for (int n = 0; n < 2; ++n) *(f32x4*)(out + (size_t)PG8_ROW(u, ai, m) * D + PG8_COL(u, bj, n)) = xv[m][n] * ALPHA + gv[bj][n] * acc[ai][bj][m][n];
            }
    }
};
struct EpiQ {
    bf16_t* Q;
    DEVI void operator()(const f32x4 (&acc)[2][2][4][2], const pg8::Unit& u, int wr, int wc, int fr, int fq) const {
#pragma unroll
        for (int ai = 0; ai < 2; ++ai)
#pragma unroll
            for (int m = 0; m < 4; ++m) {
                const int row = PG8_ROW(u, ai, m);
#pragma unroll
                for (int bj = 0; bj < 2; ++bj) {
                    const int col = PG8_COL(u, bj, 0);
                    const f32x4 v0 = acc[ai][bj][m][0] * 1.f, v1 = acc[ai][bj][m][1] * 1.f;
                    *(u32x4*)(Q + (size_t)row * 2048 + col) = u32x4{pack2(v0[0], v0[1]), pack2(v0[2], v0[3]), pack2(v1[0], v1[1]), pack2(v1[2], v1[3])};
                }
            }
    }
};

DEVI void phase1(const Params& p, unsigned char* smem) {
    unsigned char* ws = p.ws;
    {
        pg8::Gemm g{(const bf16_t*)(ws + WS_AMOD), (const bf16_t*)(ws + WS_WTMOD), 256, NMOD, D, D};
        pg8::StaticOrder S; S.init(256, NMOD, (int)gridDim.x, (int)blockIdx.x);
        EpiMod E{(float*)(ws + WS_MOD), p.b_mod};
        pg8::gemm_phase(( LAS unsigned char*)smem, g, S, E);
    }
    const int tid = TID, lane = tid & 63, w = tid >> 6;
    {
        for (int ci = ((int)blockIdx.x - 24) * 2 + VHALF; ci >= 0 && ci < 4096; ci += NVB - 48) {
            {
            const bool isu = ci < 2048;
            const int row0 = (ci & 2047) * 8 + w * 2;
            const float* tab = isu ? p.u_tab : p.v_tab;
            unsigned char* dst = ws + (isu ? WS_UT : WS_VT);
            float* sc = (float*)(ws + (isu ? WS_USC : WS_VSC));
#pragma unroll
            for (int r = 0; r < 2; ++r) {
                const int row = row0 + r;
                const float* src = tab + (size_t)row * D + lane * 16;
                float v[16];
#pragma unroll
                for (int i = 0; i < 4; ++i) { const float4 t = *(const float4*)(src + i * 4); v[i * 4] = t.x; v[i * 4 + 1] = t.y; v[i * 4 + 2] = t.z; v[i * 4 + 3] = t.w; }
                float am = 0.f;
#pragma unroll
                for (int i = 0; i < 16; ++i) am = fmaxf(am, fabsf(v[i]));
#pragma unroll
                for (int o = 32; o > 0; o >>= 1) am = fmaxf(am, __shfl_xor(am, o));
                if (isu && !UFP4) {
                    const float scl = am > 0.f ? 224.f / am : 1.f;
                    if (lane == 0) sc[row] = am > 0.f ? am * (1.f / 224.f) : 1.f;
                    int wd[4];
#pragma unroll
                    for (int i = 0; i < 4; ++i) {
                        int t = __builtin_amdgcn_cvt_pk_fp8_f32(v[i * 4] * scl, v[i * 4 + 1] * scl, 0, false);
                        wd[i] = __builtin_amdgcn_cvt_pk_fp8_f32(v[i * 4 + 2] * scl, v[i * 4 + 3] * scl, t, true);
                    }
                    *(int4*)(dst + (size_t)row * D + lane * 16) = int4{wd[0], wd[1], wd[2], wd[3]};
                } else {
                    const float scl = am > 0.f ? 6.f / am : 1.f;
                    if (lane == 0) sc[row] = am > 0.f ? am * (1.f / 6.f) : 1.f;
                    unsigned d0 = 0u, d1 = 0u;
                    d0 = __builtin_amdgcn_cvt_scalef32_pk_fp4_f32(d0, v[0] * scl, v[1] * scl, 1.0f, 0);
                    d0 = __builtin_amdgcn_cvt_scalef32_pk_fp4_f32(d0, v[2] * scl, v[3] * scl, 1.0f, 1);
                    d0 = __builtin_amdgcn_cvt_scalef32_pk_fp4_f32(d0, v[4] * scl, v[5] * scl, 1.0f, 2);
                    d0 = __builtin_amdgcn_cvt_scalef32_pk_fp4_f32(d0, v[6] * scl, v[7] * scl, 1.0f, 3);
                    d1 = __builtin_amdgcn_cvt_scalef32_pk_fp4_f32(d1, v[8] * scl, v[9] * scl, 1.0f, 0);
                    d1 = __builtin_amdgcn_cvt_scalef32_pk_fp4_f32(d1, v[10] * scl, v[11] * scl, 1.0f, 1);
                    d1 = __builtin_amdgcn_cvt_scalef32_pk_fp4_f32(d1, v[12] * scl, v[13] * scl, 1.0f, 2);
                    d1 = __builtin_amdgcn_cvt_scalef32_pk_fp4_f32(d1, v[14] * scl, v[15] * scl, 1.0f, 3);
                    *(uint2*)(dst + (size_t)row * 512 + lane * 8) = uint2{d0, d1};
                }
            }
        }
    }
    }
}

DEVI void phase2(const Params& p, unsigned char* smem) {
    unsigned char* ws = p.ws;
    const int tid = threadIdx.x, lane = tid & 63, w = tid >> 6;
    const float* mod = (const float*)(ws + WS_MOD);
    bf16_t* u1 = (bf16_t*)(ws + WS_BUFA);
    float* gates = (float*)(ws + WS_GATES);
    float* Wg = (float*)smem;
    for (int k = tid; k < 1024; k += 512) {
        const float4 w0 = *(const float4*)(p.w_in + (size_t)k * DIN + NP), w1 = *(const float4*)(p.w_in + (size_t)k * DIN + NP + 4);
        Wg[k] = w0.x; Wg[1024 + k] = w0.y; Wg[2048 + k] = w0.z; Wg[3072 + k] = w0.w;
        Wg[4096 + k] = w1.x; Wg[5120 + k] = w1.y; Wg[6144 + k] = w1.z; Wg[7168 + k] = w1.w;
    }
    __syncthreads();
    const int nw = gridDim.x * 8;
    for (int tok0 = blockIdx.x * 8 + w; tok0 < NT; tok0 += 2 * nw) {
      float vv[2][16];
      const bool has2 = tok0 + nw < NT;
#pragma unroll
      for (int t = 0; t < 2; ++t) {
          const float* x = xrow_ptr(p, (t == 0 || has2) ? tok0 + t * nw : tok0);
#pragma unroll
          for (int i = 0; i < 4; ++i) { const float4 q4 = *(const float4*)(x + i * 256 + lane * 4); vv[t][i * 4] = q4.x; vv[t][i * 4 + 1] = q4.y; vv[t][i * 4 + 2] = q4.z; vv[t][i * 4 + 3] = q4.w; }
      }
#pragma unroll
      for (int t = 0; t < 2; ++t) {
        if (t == 1 && !has2) break;
        const int tok = tok0 + t * nw;
        const float* ms = mod + (size_t)seq_of(tok) * NMOD;
        float v[16];
#pragma unroll
        for (int i = 0; i < 16; ++i) v[i] = vv[t][i];
        float s = 0.f;
#pragma unroll
        for (int i = 0; i < 16; ++i) s += v[i];
        const float mean = wave_sum(s) * (1.f / 1024.f);
        float q = 0.f;
#pragma unroll
        for (int i = 0; i < 16; ++i) { v[i] -= mean; q += v[i] * v[i]; }
        const float rstd = rsqrtf(wave_sum(q) * (1.f / 1024.f) + LN_EPS);
        float g[8] = {0.f, 0.f, 0.f, 0.f, 0.f, 0.f, 0.f, 0.f};
#pragma unroll
        for (int i = 0; i < 4; ++i) {
            const int c = i * 256 + lane * 4;
            const float4 sh = *(const float4*)(ms + c), sc = *(const float4*)(ms + 1024 + c);
            float u[4];
            u[0] = v[i * 4] * rstd * (1.f + sc.x) + sh.x; u[1] = v[i * 4 + 1] * rstd * (1.f + sc.y) + sh.y;
            u[2] = v[i * 4 + 2] * rstd * (1.f + sc.z) + sh.z; u[3] = v[i * 4 + 3] * rstd * (1.f + sc.w) + sh.w;
            *(uint2*)(u1 + (size_t)tok * D + c) = uint2{pack2(u[0], u[1]), pack2(u[2], u[3])};
#pragma unroll
            for (int gg = 0; gg < 8; ++gg) {
                const float4 wv = *(const float4*)&Wg[gg * 1024 + c];
                g[gg] += u[0] * wv.x + u[1] * wv.y + u[2] * wv.z + u[3] * wv.w;
            }
        }
#pragma unroll
        for (int j = 0; j < 8; ++j) g[j] = wave_sum(g[j]);
        if (lane == 0) {
            const float4 b0 = *(const float4*)(p.b_in + NP), b1 = *(const float4*)(p.b_in + NP + 4);
            *(float4*)(gates + (size_t)tok * 8) = float4{g[0] + b0.x, g[1] + b0.y, g[2] + b0.z, g[3] + b0.w};
            *(float4*)(gates + (size_t)tok * 8 + 4) = float4{g[4] + b1.x, g[5] + b1.y, g[6] + b1.z, g[7] + b1.w};
        }
      }
    }
}

DEVI void phase3(const Params& p, unsigned char* smem) {
    unsigned char* ws = p.ws;
    const int lane = threadIdx.x & 63;
    pg8::Gemm g{(const bf16_t*)(ws + WS_BUFA), (const bf16_t*)(ws + WS_WTIN), NT, NP, D, D};
    pg8::StaticOrder S; S.init(NT, NP, (int)gridDim.x, (int)blockIdx.x);
    EpiP E{(bf16_t*)(ws + WS_P), p.b_in, p.out};
    pg8::gemm_phase((LAS unsigned char*)smem, g, S, E);
    if ((int)blockIdx.x >= (int)gridDim.x - 32 && (threadIdx.x >> 6) == 0) {
        const int bh = (int)blockIdx.x - ((int)gridDim.x - 32), b = bh >> 2, h = bh & 3;
        const float* gates = (const float*)(ws + WS_GATES);
        float* mst = (float*)(ws + WS_MST) + bh * 64;
        float m = 0.f;
        for (int c = 0; c < 32; ++c) {
            const int tok = b * SEQ + c * 64 + lane;
            const float gi = gates[(size_t)tok * 8 + h], gf = gates[(size_t)tok * 8 + 4 + h];
            const float bb = scan_sum_incl(logsigmoid(gf), lane);
            const float R = scan_max_incl(gi - bb, lane);
            const float B63 = __shfl(bb, 63), R63 = __shfl(R, 63);
            {
                const int ti = bh * 2048 + c * 64 + lane;
                ((float*)(ws + WS_GA))[ti] = B63 - bb + gi; ((float*)(ws + WS_BB))[ti] = bb;
                ((float*)(ws + WS_RR))[ti] = gi - bb; ((float*)(ws + WS_RPM))[ti] = R;
                if (lane == 0) ((float*)(ws + WS_BCH))[bh * 32 + c] = B63;
            }
            if (lane == 0) mst[c] = m;
            m = B63 + fmaxf(m, R63);
        }
        if (lane == 0) { mst[32] = m; p.out[O_MP + bh] = m; }
    }
}

#define LDS_BAR() do { asm volatile("s_waitcnt lgkmcnt(0)" ::: "memory"); __builtin_amdgcn_s_barrier(); asm volatile("" ::: "memory"); } while (0)
DEVI void p4_state_scan(const Params& p, unsigned char* smem, int it) {
    unsigned char* ws = p.ws;
    const int tid = TID, lane = tid & 63, w = tid >> 6, fr = lane & 15, fq = lane >> 4;
    const int bh = it >> 3, sl = it & 7, b = bh >> 2, h = bh & 3;
    bf16_t* Ks = (bf16_t*)smem;
    bf16_t* Vs = (bf16_t*)(smem + 64 * LDW * 2);
    float* gin = (float*)(smem + 64 * LDW * 2 + 64 * 24 * 2);
    const bf16_t* P = (const bf16_t*)(ws + WS_P);
    const float* gates = (const float*)(ws + WS_GATES);
    const float* mst = (const float*)(ws + WS_MST) + bh * 64;
    bf16_t* ST = (bf16_t*)(ws + WS_BUFB) + (size_t)bh * 32 * 16384;
    float* nst = (float*)(ws + WS_NST) + (size_t)bh * 32 * 128;
    f32x4 acc[2] = {f32x4{0.f, 0.f, 0.f, 0.f}, f32x4{0.f, 0.f, 0.f, 0.f}};
    float nacc = 0.f;
    u32x4 ka0, ka1, ka2, ka3, va = u32x4{0u, 0u, 0u, 0u}; float gia = 0.f, gfa = 0.f;
    u32x4 kb0, kb1, kb2, kb3, vb_ = u32x4{0u, 0u, 0u, 0u}; float gib = 0.f, gfb = 0.f;
    const int ks_ = tid >> 4, kc_ = tid & 15;
#define P4_PREFETCH(c, K0, K1, K2, K3, VR, GI, GF) do { const int _t0 = b * SEQ + (c) * 64; \
        { const bf16_t* _kp = P + (size_t)(_t0 + ks_) * NP + 1024 + h * 128 + kc_ * 8; \
          K0 = *(const u32x4*)(_kp); K1 = *(const u32x4*)(_kp + (size_t)16 * NP); K2 = *(const u32x4*)(_kp + (size_t)32 * NP); K3 = *(const u32x4*)(_kp + (size_t)48 * NP); } \
        if (tid < 128) VR = *(const u32x4*)(P + (size_t)(_t0 + (tid >> 1)) * NP + 1536 + h * 128 + sl * 16 + (tid & 1) * 8); \
        if (w == 0) { GI = ((const float*)(ws + WS_GA))[bh * 2048 + (c) * 64 + lane]; GF = ((const float*)(ws + WS_BCH))[bh * 32 + (c)]; } } while (0)
#define P4_STEP(c, K0, K1, K2, K3, VR, GI, GF) do { \
        if (w == 0) { \
            const float mc = mst[(c)], mn = mst[(c) + 1]; \
            gin[lane] = expf(GI - mn) * KSCALE; \
            if (lane == 0) gin[64] = expf(GF + mc - mn); \
        } \
        *(u32x4*)&Ks[ks_ * LDW + kc_ * 8] = K0; *(u32x4*)&Ks[(ks_ + 16) * LDW + kc_ * 8] = K1; \
        *(u32x4*)&Ks[(ks_ + 32) * LDW + kc_ * 8] = K2; *(u32x4*)&Ks[(ks_ + 48) * LDW + kc_ * 8] = K3; \
        const u32x4 v = VR; \
        LDS_BAR(); \
        if ((c) + 2 < 32) P4_PREFETCH((c) + 2, K0, K1, K2, K3, VR, GI, GF); \
        { \
            bf16_t* STc = ST + (size_t)(c) * 16384; \
            _Pragma("unroll") for (int mt = 0; mt < 2; ++mt) { \
                const int d0 = (w * 2 + mt) * 16 + fq * 4, e = sl * 16 + fr; \
                *(uint2*)(STc + e * 128 + d0) = uint2{pack2(acc[mt][0], acc[mt][1]), pack2(acc[mt][2], acc[mt][3])}; \
            } \
            if (w == 0 && lane < 16) nst[(c) * 128 + sl * 16 + lane] = nacc; \
        } \
        const float gprev = gin[64]; \
        if (tid < 128) { \
            const int s_ = tid >> 1, hf = tid & 1; \
            const float g = gin[s_]; \
            *(uint4*)&Vs[s_ * 24 + hf * 8] = uint4{pack2(bf_lo(v.x) * g, bf_hi(v.x) * g), pack2(bf_lo(v.y) * g, bf_hi(v.y) * g), \
                                                    pack2(bf_lo(v.z) * g, bf_hi(v.z) * g), pack2(bf_lo(v.w) * g, bf_hi(v.w) * g)}; \
        } \
        if (w == 0) { \
            const int d = sl * 16 + fr; \
            float a = 0.f; \
            _Pragma("unroll") for (int s_ = 0; s_ < 16; ++s_) a += bf1(Ks[(fq * 16 + s_) * LDW + d]) * gin[fq * 16 + s_]; \
            nacc = gprev * nacc + sumq(a); \
        } \
        LDS_BAR(); \
        _Pragma("unroll") for (int mt = 0; mt < 2; ++mt) { acc[mt][0] *= gprev; acc[mt][1] *= gprev; acc[mt][2] *= gprev; acc[mt][3] *= gprev; } \
        _Pragma("unroll") for (int ks = 0; ks < 2; ++ks) { \
            const bf16x8 vfr = tr_frag(Vs, 24, ks * 32, 0, lane); \
            _Pragma("unroll") for (int mt = 0; mt < 2; ++mt) { \
                const bf16x8 ka = tr_frag(Ks, LDW, ks * 32, (w * 2 + mt) * 16, lane); \
                acc[mt] = __builtin_amdgcn_mfma_f32_16x16x32_bf16(ka, vfr, acc[mt], 0, 0, 0); \
            } \
        } \
        LDS_BAR(); } while (0)
    P4_PREFETCH(0, ka0, ka1, ka2, ka3, va, gia, gfa);
    P4_PREFETCH(1, kb0, kb1, kb2, kb3, vb_, gib, gfb);
    for (int c = 0; c < 32; c += 2) {
        P4_STEP(c, ka0, ka1, ka2, ka3, va, gia, gfa);
        P4_STEP(c + 1, kb0, kb1, kb2, kb3, vb_, gib, gfb);
    }
#undef P4_STEP
#undef P4_PREFETCH
    float* Cp = p.out + O_CP + (size_t)bh * 16384;
#pragma unroll
    for (int mt = 0; mt < 2; ++mt)
#pragma unroll
        for (int j = 0; j < 4; ++j) Cp[((w * 2 + mt) * 16 + fq * 4 + j) * 128 + sl * 16 + fr] = acc[mt][j];
    if (w == 0 && lane < 16) p.out[O_NP + bh * 128 + sl * 16 + lane] = nacc;
}

DEVI void p4_sample(const Params& p, unsigned char* smem, int it) {
    unsigned char* ws = p.ws;
    const int tid = TID, lane = tid & 63, w = tid >> 6;
    const int b = it >> 2, h = it & 3;
    float* qs = (float*)smem;
    float* kg = qs + 512;
    float* vs = kg + 512;
    float* ksc = vs + 512;
    float* qS = ksc + 512;
    float* Pm = qS + 1024;
    float* qn = Pm + 16;
    const bf16_t* P = (const bf16_t*)(ws + WS_P);
    const float* gates = (const float*)(ws + WS_GATES);
    const int tok0 = NTP + b * 4;
    float gi[4], bb[4], mt_[4];
    const float m0 = p.state_m[b * 4 + h];
    {
        float cum = 0.f, R = -INFINITY;
#pragma unroll
        for (int s = 0; s < 4; ++s) {
            gi[s] = gates[(size_t)(tok0 + s) * 8 + h];
            cum += logsigmoid(gates[(size_t)(tok0 + s) * 8 + 4 + h]);
            bb[s] = cum; R = fmaxf(R, gi[s] - cum);
            mt_[s] = cum + fmaxf(m0, R);
        }
    }
    const float mnew = mt_[3];
    const float gprev = expf(bb[3] + m0 - mnew);
    float gin[4];
#pragma unroll
    for (int s = 0; s < 4; ++s) gin[s] = expf(bb[3] - bb[s] + gi[s] - mnew);
    {
        const int t = tid >> 6, dd = (tid & 63) * 2;
        const bf16_t* row = P + (size_t)(tok0 + t) * NP + h * 128 + dd;
        const unsigned uq = *(const unsigned*)(row + 512), uk = *(const unsigned*)(row + 1024), uv = *(const unsigned*)(row + 1536);
        float g = gin[0]; g = t == 1 ? gin[1] : g; g = t == 2 ? gin[2] : g; g = t == 3 ? gin[3] : g;
        qs[t * 128 + dd] = bf_lo(uq); qs[t * 128 + dd + 1] = bf_hi(uq);
        const float k0 = bf_lo(uk) * KSCALE, k1 = bf_hi(uk) * KSCALE;
        ksc[t * 128 + dd] = k0; ksc[t * 128 + dd + 1] = k1;
        kg[t * 128 + dd] = k0 * g; kg[t * 128 + dd + 1] = k1 * g;
        vs[t * 128 + dd] = bf_lo(uv); vs[t * 128 + dd + 1] = bf_hi(uv);
    }
    __syncthreads();
    const int e = tid & 127, dh = tid >> 7;
    const float* S0 = p.state_C + (size_t)(b * 4 + h) * 16384;
    float* Cs = p.out + O_CS + (size_t)(b * 4 + h) * 16384;
    const float v0 = vs[e], v1 = vs[128 + e], v2 = vs[256 + e], v3 = vs[384 + e];
    float a0 = 0.f, a1 = 0.f, a2 = 0.f, a3 = 0.f;
    for (int hh = 0; hh < 4; ++hh) {
    float Sv[16];
#pragma unroll
    for (int i = 0; i < 16; ++i) Sv[i] = S0[(dh * 64 + hh * 16 + i) * 128 + e];
#pragma unroll
    for (int i = 0; i < 16; ++i) {
        const int d = dh * 64 + hh * 16 + i;
        const float S = Sv[i];
        a0 += qs[d] * S; a1 += qs[128 + d] * S; a2 += qs[256 + d] * S; a3 += qs[384 + d] * S;
        Cs[d * 128 + e] = gprev * S + kg[d] * v0 + kg[128 + d] * v1 + kg[256 + d] * v2 + kg[384 + d] * v3;
    }
    }
    qS[(dh * 4 + 0) * 128 + e] = a0; qS[(dh * 4 + 1) * 128 + e] = a1; qS[(dh * 4 + 2) * 128 + e] = a2; qS[(dh * 4 + 3) * 128 + e] = a3;
    {
        const int t = w;
        const float* n0 = p.state_n + (size_t)(b * 4 + h) * 128;
        const float q0 = qs[t * 128 + lane], q1 = qs[t * 128 + 64 + lane];
        const float qn_ = wave_sum(q0 * n0[lane] + q1 * n0[64 + lane]);
        if (lane == 0) qn[t] = qn_;
#pragma unroll
        for (int s = 0; s < 4; ++s) {
            const float d = wave_sum(q0 * ksc[s * 128 + lane] + q1 * ksc[s * 128 + 64 + lane]);
            if (lane == 0) Pm[t * 4 + s] = (s <= t) ? d * expf(bb[t] - bb[s] + gi[s] - mt_[t]) : 0.f;
        }
        if (t == 0) {
            const float n_a = gprev * n0[lane] + kg[lane] + kg[128 + lane] + kg[256 + lane] + kg[384 + lane];
            const float n_b = gprev * n0[64 + lane] + kg[64 + lane] + kg[192 + lane] + kg[320 + lane] + kg[448 + lane];
            p.out[O_NS + (size_t)(b * 4 + h) * 128 + lane] = n_a;
            p.out[O_NS + (size_t)(b * 4 + h) * 128 + 64 + lane] = n_b;
            if (lane == 0) p.out[O_MS + b * 4 + h] = mnew;
        }
    }
    __syncthreads();
    {
        const int t = w;
        const float wprev = expf(bb[t] + m0 - mt_[t]);
        const float p0 = Pm[t * 4], p1 = Pm[t * 4 + 1], p2 = Pm[t * 4 + 2], p3 = Pm[t * 4 + 3];
        const float den = wprev * qn[t] + p0 + p1 + p2 + p3;
        const float inv = 1.f / fmaxf(fabsf(den), expf(-mt_[t]));
        float hv[2];
#pragma unroll
        for (int r = 0; r < 2; ++r) {
            const int ee = lane + 64 * r;
            const float num = wprev * (qS[t * 128 + ee] + qS[(4 + t) * 128 + ee]) + p0 * vs[ee] + p1 * vs[128 + ee] + p2 * vs[256 + ee] + p3 * vs[384 + ee];
            hv[r] = num * inv;
        }
        const float mean = wave_sum(hv[0] + hv[1]) * (1.f / 128.f);
        const float c0 = hv[0] - mean, c1 = hv[1] - mean;
        const float rstd = rsqrtf(wave_sum(c0 * c0 + c1 * c1) * (1.f / 128.f) + LN_EPS);
        bf16_t* ym = (bf16_t*)(ws + WS_BUFA) + (size_t)(tok0 + t) * D + 512 + h * 128;
        const bf16_t* orow = P + (size_t)(tok0 + t) * NP + 2048 + h * 128;
#pragma unroll
        for (int r = 0; r < 2; ++r) {
            const int ee = lane + 64 * r;
            const float y = (r ? c1 : c0) * rstd * p.mh_norm_g[h * 128 + ee] * sigmoidf_(bf1(orow[ee]));
            ym[ee] = (bf16_t)(pack2(y, 0.f) & 0xFFFFu);
        }
    }
    __syncthreads();
}

DEVI void p4_pool(const Params& p, unsigned char* smem, int it) {
    unsigned char* ws = p.ws;
    const int tid = TID, lane = tid & 63, w = tid >> 6, wr = w >> 1, wc = w & 1, fr = lane & 15, fq = lane >> 4;
    const int tt = it >> 2, g = it & 3, win = 2 << g;
    bf16_t* Ad = (bf16_t*)smem;
    bf16_t* Bw = (bf16_t*)(smem + 128 * LDW * 2);
    const bf16_t* P = (const bf16_t*)(ws + WS_P);
#pragma unroll
    for (int i = 0; i < 8; ++i) {
        const int ch = tid + i * 256, r = ch >> 4, kc = ch & 15;
        *(uint4*)&Bw[r * LDW + kc * 8] = *(const uint4*)((const bf16_t*)(ws + WS_WTPOOL) + g * 16384 + r * 128 + kc * 8);
    }
    const int c4 = (tid & 31) * 4;
    if (tt < 128) {
        const int r0 = (tid >> 5) * 16;
        const int tokb = tt * 128 + r0;
        const int t0 = tokb & (SEQ - 1);
        const bf16_t* col = P + g * 128 + c4;
        float s0 = 0.f, s1 = 0.f, s2 = 0.f, s3 = 0.f;
        {
            uint2 zh[15];
#pragma unroll
            for (int k = 1; k < 16; ++k) zh[k - 1] = (k < win && t0 - k >= 0) ? *(const uint2*)(col + (size_t)(tokb - k) * NP) : uint2{0u, 0u};
#pragma unroll
            for (int k = 0; k < 15; ++k) { s0 += bf_lo(zh[k].x); s1 += bf_hi(zh[k].x); s2 += bf_lo(zh[k].y); s3 += bf_hi(zh[k].y); }
        }
        for (int hp = 0; hp < 2; ++hp) {
            uint2 zz[8], zo[8];
#pragma unroll
            for (int i = 0; i < 8; ++i) {
                const int ii = hp * 8 + i;
                zz[i] = *(const uint2*)(col + (size_t)(tokb + ii) * NP);
                zo[i] = (t0 + ii - win + 1 >= 0) ? *(const uint2*)(col + (size_t)(tokb + ii - win + 1) * NP) : uint2{0u, 0u};
            }
#pragma unroll
            for (int i = 0; i < 8; ++i) {
                const int ii = hp * 8 + i, t = t0 + ii;
                const float u0 = bf_lo(zz[i].x), u1 = bf_hi(zz[i].x), u2 = bf_lo(zz[i].y), u3 = bf_hi(zz[i].y);
                s0 += u0; s1 += u1; s2 += u2; s3 += u3;
                const float ic = 1.f / (float)min(t + 1, win);
                *(uint2*)&Ad[(r0 + ii) * LDW + c4] = uint2{pack2(s0 * ic - u0, s1 * ic - u1), pack2(s2 * ic - u2, s3 * ic - u3)};
                s0 -= bf_lo(zo[i].x); s1 -= bf_hi(zo[i].x); s2 -= bf_lo(zo[i].y); s3 -= bf_hi(zo[i].y);
            }
        }
    } else {
        const float ic = 1.f / (float)win;
        for (int i = 0; i < 4; ++i) {
            const int sq = (tid >> 5) * 4 + i;
            const int b = (tt - 128) * 32 + sq;
            const float* buf = p.state_pool + (size_t)b * 15 * 512 + g * 128 + c4;
            const bf16_t* col = P + (size_t)(NTP + b * 4) * NP + g * 128 + c4;
            float s0 = 0.f, s1 = 0.f, s2 = 0.f, s3 = 0.f;
            for (int k = 1; k < win; ++k) { const float4 z = *(const float4*)(buf + (15 - k) * 512); s0 += z.x; s1 += z.y; s2 += z.z; s3 += z.w; }
            for (int t = 0; t < 4; ++t) {
                const uint2 z = *(const uint2*)(col + (size_t)t * NP);
                const float u0 = bf_lo(z.x), u1 = bf_hi(z.x), u2 = bf_lo(z.y), u3 = bf_hi(z.y);
                s0 += u0; s1 += u1; s2 += u2; s3 += u3;
                *(uint2*)&Ad[(sq * 4 + t) * LDW + c4] = uint2{pack2(s0 * ic - u0, s1 * ic - u1), pack2(s2 * ic - u2, s3 * ic - u3)};
                const int zi = 15 + t - win + 1;
                if (zi < 15) { const float4 zo = *(const float4*)(buf + zi * 512); s0 -= zo.x; s1 -= zo.y; s2 -= zo.z; s3 -= zo.w; }
                else { const uint2 zo = *(const uint2*)(col + (size_t)(zi - 15) * NP); s0 -= bf_lo(zo.x); s1 -= bf_hi(zo.x); s2 -= bf_lo(zo.y); s3 -= bf_hi(zo.y); }
            }
        }
    }
    __syncthreads();
    f32x4 acc[4][4];
    mma_lds128(Ad, Bw, acc);
    bf16_t* ym = (bf16_t*)(ws + WS_BUFA);
#pragma unroll
    for (int m = 0; m < 4; ++m) {
        const int row = tt * 128 + wr * 64 + m * 16 + fr;
#pragma unroll
        for (int n = 0; n < 4; ++n) {
            const int col = g * 128 + wc * 64 + n * 16 + fq * 4;
            const float4 ps = *(const float4*)(p.pool_scale + col);
            *(uint2*)(ym + (size_t)row * D + col) = uint2{pack2(acc[m][n][0] * ps.x, acc[m][n][1] * ps.y), pack2(acc[m][n][2] * ps.z, acc[m][n][3] * ps.w)};
        }
    }
    __syncthreads();
}

DEVI void phase4(const Params& p, unsigned char* smem_all) {
    unsigned char* smem = smem_all + VHALF * SMEM_HALF;
    for (int it0 = (int)blockIdx.x * 2; it0 < 512; it0 += NVB) p4_sample(p, smem, it0 + VHALF);
    const int nscan = min(128, (int)gridDim.x / 2);
    if ((int)blockIdx.x < nscan) { for (int it0 = (int)blockIdx.x * 2; it0 < 256; it0 += nscan * 2) p4_state_scan(p, smem, it0 + VHALF); return; }
    const int rb = (int)blockIdx.x - nscan, nrb = ((int)gridDim.x - nscan) * 2;
    for (int it0 = rb * 2; it0 < 528; it0 += nrb) p4_pool(p, smem, it0 + VHALF);
}

DEVI void phase5(const Params& p, unsigned char* smem_all) {
    unsigned char* smem = smem_all + VHALF * SMEM_HALF;
    unsigned char* ws = p.ws;
    const int tid = TID, lane = tid & 63, w = tid >> 6, fr = lane & 15, fq = lane >> 4;
    bf16_t* Ks = (bf16_t*)smem;
    bf16_t* Vs = (bf16_t*)(smem + 64 * LDW * 2);
    bf16_t* Ps = (bf16_t*)(smem + 2 * 64 * LDW * 2) + w * 16 * LDT;
    const bf16_t* P = (const bf16_t*)(ws + WS_P);
    const float* gates = (const float*)(ws + WS_GATES);
    for (int it0 = blockIdx.x * 2; it0 < 1024; it0 += NVB) {
        const int item = it0 + VHALF;
        const int bh = item >> 5, c = item & 31, b = bh >> 2, h = bh & 3;
        const int tok0 = b * SEQ + c * 64;
        const float gi = gates[(size_t)(tok0 + lane) * 8 + h], gf = gates[(size_t)(tok0 + lane) * 8 + 4 + h];
        const float bb = scan_sum_incl(logsigmoid(gf), lane);
        const float rr = gi - bb;
        const float R = scan_max_incl(rr, lane);
        const float mc = ((const float*)(ws + WS_MST))[bh * 64 + c];
        const float mt_all = bb + fmaxf(mc, R);
        const int trow = w * 16 + fr;
        const float bt = __shfl(bb, trow), mt = __shfl(mt_all, trow);
#pragma unroll
        for (int i = 0; i < 4; ++i) {
            const int ch = tid + i * 256, s = ch >> 4, kc = ch & 15;
            const bf16_t* src = P + (size_t)(tok0 + s) * NP + h * 128 + kc * 8;
            *(uint4*)&Ks[s * LDW + kc * 8] = *(const uint4*)(src + 1024);
            *(uint4*)&Vs[s * LDW + kc * 8] = *(const uint4*)(src + 1536);
        }
        bf16x8 qa[4];
        const bf16_t* qrow = P + (size_t)(tok0 + trow) * NP + 512 + h * 128 + fq * 8;
#pragma unroll
        for (int ks = 0; ks < 4; ++ks) qa[ks] = *(const bf16x8*)(qrow + ks * 32);
        __syncthreads();
        f32x4 sacc[4];
#pragma unroll
        for (int nt = 0; nt < 4; ++nt) {
            sacc[nt] = f32x4{0.f, 0.f, 0.f, 0.f};
#pragma unroll
            for (int ks = 0; ks < 4; ++ks) {
                const bf16x8 kb = *(const bf16x8*)&Ks[(nt * 16 + fr) * LDW + ks * 32 + fq * 8];
                sacc[nt] = __builtin_amdgcn_mfma_f32_16x16x32_bf16(kb, qa[ks], sacc[nt], 0, 0, 0);
            }
        }
        float rowsum = 0.f;
#pragma unroll
        for (int nt = 0; nt < 4; ++nt) {
            float pv[4];
#pragma unroll
            for (int j = 0; j < 4; ++j) {
                const int s = nt * 16 + fq * 4 + j;
                const float rs = __shfl(rr, s);
                const float dd = (s <= trow) ? expf(bt - mt + rs) : 0.f;
                pv[j] = sacc[nt][j] * KSCALE * dd;
                rowsum += pv[j];
            }
            *(uint2*)&Ps[fr * LDT + nt * 16 + fq * 4] = uint2{pack2(pv[0], pv[1]), pack2(pv[2], pv[3])};
        }
        rowsum = sumq(rowsum);
        float qn = 0.f;
        {
            const float* nc = (const float*)(ws + WS_NST) + (size_t)(bh * 32 + c) * 128 + fq * 8;
#pragma unroll
            for (int ks = 0; ks < 4; ++ks) {
                const float4 n0 = *(const float4*)(nc + ks * 32), n1 = *(const float4*)(nc + ks * 32 + 4);
                const u32x4 qq = __builtin_bit_cast(u32x4, qa[ks]);
                qn += bf_lo(qq.x) * n0.x + bf_hi(qq.x) * n0.y + bf_lo(qq.y) * n0.z + bf_hi(qq.y) * n0.w
                    + bf_lo(qq.z) * n1.x + bf_hi(qq.z) * n1.y + bf_lo(qq.w) * n1.z + bf_hi(qq.w) * n1.w;
            }
            qn = sumq(qn);
        }
        f32x4 oacc[8];
        const bf16_t* STc = (const bf16_t*)(ws + WS_BUFB) + (size_t)(bh * 32 + c) * 16384;
#pragma unroll
        for (int nt = 0; nt < 8; ++nt) {
            oacc[nt] = f32x4{0.f, 0.f, 0.f, 0.f};
#pragma unroll
            for (int ks = 0; ks < 4; ++ks) {
                const bf16x8 sb = *(const bf16x8*)(STc + (nt * 16 + fr) * 128 + ks * 32 + fq * 8);
                oacc[nt] = __builtin_amdgcn_mfma_f32_16x16x32_bf16(sb, qa[ks], oacc[nt], 0, 0, 0);
            }
            if (nt & 1) asm volatile("" ::: "memory");
        }
        const float wprev = expf(bt + mc - mt);
#pragma unroll
        for (int nt = 0; nt < 8; ++nt) { oacc[nt][0] *= wprev; oacc[nt][1] *= wprev; oacc[nt][2] *= wprev; oacc[nt][3] *= wprev; }
        __syncthreads();
#pragma unroll
        for (int ks = 0; ks < 2; ++ks) {
            const bf16x8 pf = *(const bf16x8*)&Ps[fr * LDT + ks * 32 + fq * 8];
#pragma unroll
            for (int nt = 0; nt < 8; ++nt) {
                const bf16x8 vt = tr_frag(Vs, LDW, ks * 32, nt * 16, lane);
                oacc[nt] = __builtin_amdgcn_mfma_f32_16x16x32_bf16(vt, pf, oacc[nt], 0, 0, 0);
            }
        }
        const float den = wprev * qn + rowsum;
        const float inv = 1.f / fmaxf(fabsf(den), expf(-mt));
        float s1 = 0.f;
#pragma unroll
        for (int nt = 0; nt < 8; ++nt)
#pragma unroll
            for (int j = 0; j < 4; ++j) { oacc[nt][j] *= inv; s1 += oacc[nt][j]; }
        const float mean = sumq(s1) * (1.f / 128.f);
        float s2 = 0.f;
#pragma unroll
        for (int nt = 0; nt < 8; ++nt)
#pragma unroll
            for (int j = 0; j < 4; ++j) { oacc[nt][j] -= mean; s2 += oacc[nt][j] * oacc[nt][j]; }
        const float rstd = rsqrtf(sumq(s2) * (1.f / 128.f) + LN_EPS);
        bf16_t* ym = (bf16_t*)(ws + WS_BUFA) + (size_t)(tok0 + trow) * D + 512 + h * 128;
        const bf16_t* orow = P + (size_t)(tok0 + trow) * NP + 2048 + h * 128;
#pragma unroll
        for (int nt = 0; nt < 8; ++nt) {
            const int e = nt * 16 + fq * 4;
            const float4 gg = *(const float4*)(p.mh_norm_g + h * 128 + e);
            const uint2 oo = *(const uint2*)(orow + e);
            const float y0 = oacc[nt][0] * rstd * gg.x * sigmoidf_(bf_lo(oo.x)), y1 = oacc[nt][1] * rstd * gg.y * sigmoidf_(bf_hi(oo.x));
            const float y2 = oacc[nt][2] * rstd * gg.z * sigmoidf_(bf_lo(oo.y)), y3 = oacc[nt][3] * rstd * gg.w * sigmoidf_(bf_hi(oo.y));
            *(uint2*)(ym + e) = uint2{pack2(y0, y1), pack2(y2, y3)};
        }
        __syncthreads();
    }
}

struct EpiOutPart {
    const float* xs; const float* mod; float* out; float* part; int ks;
    DEVI void operator()(const f32x4 (&acc)[2][2][4][2], const pg8::Unit& u, int wr, int wc, int fr, int fq) const {
#pragma unroll
        for (int ai = 0; ai < 2; ++ai)
#pragma unroll
            for (int m = 0; m < 4; ++m) {
                const int row = PG8_ROW(u, ai, m), rs = row - NTP;
                const float* x = xs + (size_t)rs * D;
                const float* g1 = mod + (size_t)seq_of(row) * NMOD + 2048;
                float* dst = ks == 0 ? out + (size_t)row * D : part + ((size_t)(ks - 1) * NTS + rs) * D;
                f32x4 xv[2][2], gv[2][2];
#pragma unroll
                for (int bj = 0; bj < 2; ++bj)
#pragma unroll
                    for (int n = 0; n < 2; ++n) { const int col = PG8_COL(u, bj, n); gv[bj][n] = *(const f32x4*)(g1 + col); xv[bj][n] = ks == 0 ? *(const f32x4*)(x + col) * ALPHA : f32x4{0.f, 0.f, 0.f, 0.f}; }
#pragma unroll
                for (int bj = 0; bj < 2; ++bj)
#pragma unroll
                    for (int n = 0; n < 2; ++n) *(f32x4*)(dst + PG8_COL(u, bj, n)) = xv[bj][n] + (gv[bj][n] + 1.f) * acc[ai][bj][m][n];
            }
    }
};

DEVI void phase6(const Params& p, unsigned char* smem) {
    unsigned char* ws = p.ws;
    {
        pg8::Gemm g{(const bf16_t*)(ws + WS_BUFA), (const bf16_t*)(ws + WS_WTOUT), NTP, D, D, D};
        pg8::StaticOrder S; S.init(NTP, D, (int)gridDim.x, (int)blockIdx.x);
        EpiOut E{p.x_prompt, p.x_sample, (const float*)(ws + WS_MOD), p.out};
        pg8::gemm_phase((LAS unsigned char*)smem, g, S, E);
    }
    {
        const int q = (int)blockIdx.x - ((int)gridDim.x - 32);
        const int qq = q < 0 ? 0 : q, ks = qq & 3;
        pg8::Gemm g{(const bf16_t*)(ws + WS_BUFA) + ks * 256, (const bf16_t*)(ws + WS_WTOUT) + ks * 256, NT, D, 256, D};
        pg8::OneUnit S{q >= 0, pg8::Unit{64 + (qq >> 4), (qq >> 2) & 3}};
        EpiOutPart E{p.x_sample, (const float*)(ws + WS_MOD), p.out, (float*)(ws + WS_PART), ks};
        pg8::gemm_phase((LAS unsigned char*)smem, g, S, E);
    }
}

DEVI void phase7(const Params& p) {
    unsigned char* ws = p.ws;
    const int tid = threadIdx.x, lane = tid & 63, w = tid >> 6;
    const float* mod = (const float*)(ws + WS_MOD);
    bf16_t* u2 = (bf16_t*)(ws + WS_BUFB);
    const int nw = gridDim.x * 8;
    for (int tok0 = blockIdx.x * 8 + w; tok0 < NT; tok0 += 2 * nw) {
        float v[2][16];
        const bool has2 = tok0 + nw < NT;
#pragma unroll
        for (int t = 0; t < 2; ++t) {
            const int tok = (t == 0 || has2) ? tok0 + t * nw : tok0;
            const float* x = p.out + (size_t)tok * D;
#pragma unroll
            for (int i = 0; i < 4; ++i) { const float4 q4 = *(const float4*)(x + i * 256 + lane * 4); v[t][i * 4] = q4.x; v[t][i * 4 + 1] = q4.y; v[t][i * 4 + 2] = q4.z; v[t][i * 4 + 3] = q4.w; }
            if (tok >= NTP) {
                const float* pp = (const float*)(ws + WS_PART) + (size_t)(tok - NTP) * D;
#pragma unroll
                for (int k = 0; k < 3; ++k)
#pragma unroll
                    for (int i = 0; i < 4; ++i) { const float4 q4 = *(const float4*)(pp + (size_t)k * NTS * D + i * 256 + lane * 4); v[t][i * 4] += q4.x; v[t][i * 4 + 1] += q4.y; v[t][i * 4 + 2] += q4.z; v[t][i * 4 + 3] += q4.w; }
                if (t == 0 || has2) {
                    float* xw = p.out + (size_t)tok * D;
#pragma unroll
                    for (int i = 0; i < 4; ++i) *(float4*)(xw + i * 256 + lane * 4) = float4{v[t][i * 4], v[t][i * 4 + 1], v[t][i * 4 + 2], v[t][i * 4 + 3]};
                }
            }
        }
#pragma unroll
        for (int t = 0; t < 2; ++t) {
            if (t == 1 && !has2) break;
            const int tok = tok0 + t * nw;
            const float* ms = mod + (size_t)seq_of(tok) * NMOD;
            float s = 0.f;
#pragma unroll
            for (int i = 0; i < 16; ++i) s += v[t][i];
            float mean = wave_sum(s) * (1.f / 1024.f);
            float q = 0.f;
#pragma unroll
            for (int i = 0; i < 16; ++i) { v[t][i] -= mean; q += v[t][i] * v[t][i]; }
            float rstd = rsqrtf(wave_sum(q) * (1.f / 1024.f) + LN_EPS);
            s = 0.f;
#pragma unroll
            for (int i = 0; i < 4; ++i) {
                const int c = i * 256 + lane * 4;
                const float4 g = *(const float4*)(p.ln1_g + c), bq = *(const float4*)(p.ln1_b + c);
                v[t][i * 4] = v[t][i * 4] * rstd * g.x + bq.x; v[t][i * 4 + 1] = v[t][i * 4 + 1] * rstd * g.y + bq.y;
                v[t][i * 4 + 2] = v[t][i * 4 + 2] * rstd * g.z + bq.z; v[t][i * 4 + 3] = v[t][i * 4 + 3] * rstd * g.w + bq.w;
                s += v[t][i * 4] + v[t][i * 4 + 1] + v[t][i * 4 + 2] + v[t][i * 4 + 3];
            }
            mean = wave_sum(s) * (1.f / 1024.f);
            q = 0.f;
#pragma unroll
            for (int i = 0; i < 16; ++i) { v[t][i] -= mean; q += v[t][i] * v[t][i]; }
            rstd = rsqrtf(wave_sum(q) * (1.f / 1024.f) + LN_EPS);
#pragma unroll
            for (int i = 0; i < 4; ++i) {
                const int c = i * 256 + lane * 4;
                const float4 sh = *(const float4*)(ms + 3072 + c), sc = *(const float4*)(ms + 4096 + c);
                *(uint2*)(u2 + (size_t)tok * D + c) = uint2{pack2(v[t][i * 4] * rstd * (1.f + sc.x) + sh.x, v[t][i * 4 + 1] * rstd * (1.f + sc.y) + sh.y),
                                                            pack2(v[t][i * 4 + 2] * rstd * (1.f + sc.z) + sh.z, v[t][i * 4 + 3] * rstd * (1.f + sc.w) + sh.w)};
            }
        }
    }
}

DEVI void combine_pair(const int* k0, const int* k1, int* ed, float* gd) {
        int ka[16], kb[16];
#pragma unroll
        for (int i = 0; i < 4; ++i) {
            const int4 a = *(const int4*)(k0 + i * 4), b = *(const int4*)(k1 + i * 4);
            ka[i * 4] = a.x; ka[i * 4 + 1] = a.y; ka[i * 4 + 2] = a.z; ka[i * 4 + 3] = a.w;
            kb[i * 4] = b.x; kb[i * 4 + 1] = b.y; kb[i * 4 + 2] = b.z; kb[i * 4 + 3] = b.w;
        }
        float va[16], vb[16];
#pragma unroll
        for (int i = 0; i < 16; ++i) { va[i] = key_val(ka[i], 0x7F); vb[i] = key_val(kb[i], 0x7F); }
        int R[16];
#define CAND(i, j) key_enc(va[i] + vb[j], ((i) << 4) | (j), 0xFF)
        {
            int N0[16] = {CAND(0,0), CAND(0,1), CAND(0,2), CAND(0,3), CAND(0,4), CAND(0,5), CAND(0,6), CAND(0,7), CAND(0,8), CAND(0,9), CAND(0,10), CAND(0,11), CAND(0,12), CAND(0,13), CAND(0,14), CAND(0,15)};
            bitonic_sort_desc<16>(N0);
#pragma unroll
            for (int i = 0; i < 16; ++i) R[i] = N0[i];
        }
        {
            int N1[16] = {CAND(1,0), CAND(1,1), CAND(1,2), CAND(1,3), CAND(1,4), CAND(1,5), CAND(1,6), CAND(1,7), CAND(2,0), CAND(2,1), CAND(2,2), CAND(2,3), CAND(2,4), CAND(3,0), CAND(3,1), CAND(3,2)};
            bitonic_sort_desc<16>(N1);
#pragma unroll
            for (int i = 0; i < 16; ++i) R[i] = max(R[i], N1[15 - i]);
            bitonic_merge16_desc(R);
        }
        {
            int N2[16] = {CAND(3,3), CAND(4,0), CAND(4,1), CAND(4,2), CAND(5,0), CAND(5,1), CAND(6,0), CAND(6,1), CAND(7,0), CAND(7,1), CAND(8,0), CAND(9,0), CAND(10,0), CAND(11,0), CAND(12,0), CAND(13,0)};
            bitonic_sort_desc<16>(N2);
#pragma unroll
            for (int i = 0; i < 16; ++i) R[i] = max(R[i], N2[15 - i]);
            bitonic_merge16_desc(R);
        }
        {
            int N3[16];
            N3[0] = max(CAND(14,0), CAND(15,0)); N3[1] = min(CAND(14,0), CAND(15,0));
#pragma unroll
            for (int i = 2; i < 16; ++i) N3[i] = (int)0x80000000;
#pragma unroll
            for (int i = 0; i < 16; ++i) R[i] = max(R[i], N3[15 - i]);
            bitonic_merge16_desc(R);
        }
#undef CAND
        float val[16]; int ex[16];
#pragma unroll
        for (int k = 0; k < 16; ++k) {
            const int i = (R[k] >> 4) & 15, j = R[k] & 15;
            const int a = k0[i], b = k1[j];
            val[k] = key_val(a, 0x7F) + key_val(b, 0x7F);
            ex[k] = (a & 0x7F) * 128 + (b & 0x7F);
        }
        float mx = val[0];
#pragma unroll
        for (int k = 1; k < 16; ++k) mx = fmaxf(mx, val[k]);
        float sum = 0.f;
#pragma unroll
        for (int k = 0; k < 16; ++k) { val[k] = expf(val[k] - mx); sum += val[k]; }
        const float inv = 1.f / sum;
#pragma unroll
        for (int k = 0; k < 16; k += 4) {
            *(int4*)(ed + k) = int4{ex[k], ex[k + 1], ex[k + 2], ex[k + 3]};
            *(float4*)(gd + k) = float4{val[k] * inv, val[k + 1] * inv, val[k + 2] * inv, val[k + 3] * inv};
        }
}

DEVI void phase8a(const Params& p, unsigned char* smem) {
    unsigned char* ws = p.ws;
    pg8::Gemm g{(const bf16_t*)(ws + WS_BUFB), (const bf16_t*)(ws + WS_WTQ), NT, 2048, D, D};
    pg8::StaticOrder S; S.init(NT, 2048, (int)gridDim.x, (int)blockIdx.x);
    EpiQ E{(bf16_t*)(ws + WS_Q)};
    pg8::gemm_phase((LAS unsigned char*)smem, g, S, E);
}

DEVI void phase8(const Params& p, unsigned char* smem_all) {
    unsigned char* smem = smem_all + VHALF * SMEM_HALF;
    unsigned char* ws = p.ws;
    const int tid = TID, lane = tid & 63, w = tid >> 6, wr = w >> 1, wc = w & 1, fr = lane & 15, fq = lane >> 4;
    const bf16_t* Q = (const bf16_t*)(ws + WS_Q);
    const int lr = tid >> 4, lkc = tid & 15;
    u32x4 qr[8];
    {
        const int item = (int)blockIdx.x * 2 + VHALF;
        if (item < 132 * 16) {
            const int mt = item >> 4, hp = item & 15;
#pragma unroll
            for (int i = 0; i < 8; ++i) {
                qr[i] = *(const u32x4*)(Q + (size_t)(mt * 128 + lr + 16 * i) * 2048 + hp * 128 + lkc * 8);
            }
        }
    }
    for (int it0 = blockIdx.x * 2; it0 < 132 * 16; it0 += NVB) {
        const int item = it0 + VHALF;
        const int mt = item >> 4, hp = item & 15;
        f32x4 acc[4][4];
        bf16_t* Qs = (bf16_t*)smem;
        bf16_t* Kb = (bf16_t*)(smem + 128 * LDW * 2);
#pragma unroll
        for (int i = 0; i < 8; ++i) {
            *(u32x4*)&Qs[(lr + 16 * i) * LDW + lkc * 8] = qr[i];
            *(u32x4*)&Kb[(lr + 16 * i) * LDW + lkc * 8] = *(const u32x4*)((const bf16_t*)(ws + WS_KEYS) + hp * 16384 + (lr + 16 * i) * 128 + lkc * 8);
        }
        LDS_BAR();
        mma_lds128(Qs, Kb, acc);
        LDS_BAR();
        float* Sc = (float*)smem;
#pragma unroll
        for (int m = 0; m < 4; ++m)
#pragma unroll
            for (int n = 0; n < 4; ++n) {
                float* d = &Sc[(wr * 64 + m * 16 + fr) * 130 + wc * 64 + n * 16 + fq * 4];
                d[0] = acc[m][n][0]; d[1] = acc[m][n][1]; d[2] = acc[m][n][2]; d[3] = acc[m][n][3];
            }
        if (it0 + NVB < 132 * 16) {
            const int itn = it0 + NVB + VHALF, mtn = itn >> 4, hpn = itn & 15;
#pragma unroll
            for (int i = 0; i < 8; ++i) {
                qr[i] = *(const u32x4*)(Q + (size_t)(mtn * 128 + lr + 16 * i) * 2048 + hpn * 128 + lkc * 8);
            }
        }
        LDS_BAR();
        {
            const int row = tid >> 1, half = tid & 1;
            const float* sr = &Sc[row * 130 + half];
            int R[16];
#pragma unroll
            for (int g = 0; g < 4; ++g) {
                int Nn[16];
#pragma unroll
                for (int i = 0; i < 16; ++i) { const int idx = 2 * (g * 16 + i) + half; Nn[i] = key_enc(sr[2 * (g * 16 + i)], idx, 0x7F); }
                bitonic_sort_desc<16>(Nn);
                if (g == 0) {
#pragma unroll
                    for (int i = 0; i < 16; ++i) R[i] = Nn[i];
                } else {
#pragma unroll
                    for (int i = 0; i < 16; ++i) R[i] = max(R[i], Nn[15 - i]);
                    bitonic_merge16_desc(R);
                }
            }
            int T[16];
#pragma unroll
            for (int i = 0; i < 16; ++i) T[i] = __shfl_xor(R[15 - i], 1);
#pragma unroll
            for (int i = 0; i < 16; ++i) R[i] = max(R[i], T[i]);
            bitonic_merge16_desc(R);
            LDS_BAR();
            if (half == 0) {
                int* dst = (int*)smem + row * 16;
                *(int4*)dst = int4{R[0], R[1], R[2], R[3]}; *(int4*)(dst + 4) = int4{R[4], R[5], R[6], R[7]};
                *(int4*)(dst + 8) = int4{R[8], R[9], R[10], R[11]}; *(int4*)(dst + 12) = int4{R[12], R[13], R[14], R[15]};
            }
        }
        LDS_BAR();
        if (threadIdx.x < 128) {
            const int tok = mt * 128 + (int)threadIdx.x, hh = hp >> 1;
            combine_pair((const int*)smem_all + threadIdx.x * 16, (const int*)(smem_all + SMEM_HALF) + threadIdx.x * 16,
                         (int*)(ws + WS_EG) + (size_t)tok * 128 + hh * 16, (float*)(ws + WS_GG) + (size_t)tok * 128 + hh * 16);
        }
        LDS_BAR();
    }
}

DEVI float dpp_sum_to_lane63(float v) {
    v += __builtin_bit_cast(float, __builtin_amdgcn_update_dpp(0, __builtin_bit_cast(int, v), 0x111, 0xf, 0xf, true));
    v += __builtin_bit_cast(float, __builtin_amdgcn_update_dpp(0, __builtin_bit_cast(int, v), 0x112, 0xf, 0xf, true));
    v += __builtin_bit_cast(float, __builtin_amdgcn_update_dpp(0, __builtin_bit_cast(int, v), 0x114, 0xf, 0xf, true));
    v += __builtin_bit_cast(float, __builtin_amdgcn_update_dpp(0, __builtin_bit_cast(int, v), 0x118, 0xf, 0xf, true));
    v += __builtin_bit_cast(float, __builtin_amdgcn_update_dpp(0, __builtin_bit_cast(int, v), 0x142, 0xa, 0xf, false));
    v += __builtin_bit_cast(float, __builtin_amdgcn_update_dpp(0, __builtin_bit_cast(int, v), 0x143, 0xc, 0xf, false));
    return v;
}
DEVI float dpp_sum_half(float v) {
    v += __builtin_bit_cast(float, __builtin_amdgcn_update_dpp(0, __builtin_bit_cast(int, v), 0x111, 0xf, 0xf, true));
    v += __builtin_bit_cast(float, __builtin_amdgcn_update_dpp(0, __builtin_bit_cast(int, v), 0x112, 0xf, 0xf, true));
    v += __builtin_bit_cast(float, __builtin_amdgcn_update_dpp(0, __builtin_bit_cast(int, v), 0x114, 0xf, 0xf, true));
    v += __builtin_bit_cast(float, __builtin_amdgcn_update_dpp(0, __builtin_bit_cast(int, v), 0x118, 0xf, 0xf, true));
    v += __builtin_bit_cast(float, __builtin_amdgcn_update_dpp(0, __builtin_bit_cast(int, v), 0x142, 0xa, 0xf, false));
    return v;
}
DEVI float rdlane(float v, int l) { return __builtin_bit_cast(float, __builtin_amdgcn_readlane(__builtin_bit_cast(int, v), l)); }
DEVI int rdlanei(int v, int l) { return __builtin_amdgcn_readlane(v, l); }

DEVI void phase10(const Params& p, unsigned char* smem) {
    (void)smem;
    unsigned char* ws = p.ws;
    const int tid = threadIdx.x, lane = tid & 63, w = tid >> 6;
    const unsigned char* UT = ws + WS_UT;
    const unsigned char* VT = ws + WS_VT;
    const float* USC = (const float*)(ws + WS_USC);
    const float* VSC = (const float*)(ws + WS_VSC);
    const bf16_t* u2 = (const bf16_t*)(ws + WS_BUFB);
    const float* mod = (const float*)(ws + WS_MOD);
    unsigned* cnt = (unsigned*)(ws + WS_CTL) + CW_CNT;
    for (;;) {
        int tok = 0;
        if (lane == 0) tok = (int)atomicAdd(cnt, 1u);
        tok = __builtin_amdgcn_readfirstlane(tok);
        if (tok >= NT) break;
        const int* Eg = (const int*)(ws + WS_EG) + (size_t)tok * 128;
        const float* Gg = (const float*)(ws + WS_GG) + (size_t)tok * 128;
        const int ea = Eg[lane], eb = Eg[lane + 64];
        const float ga = Gg[lane], gb = Gg[lane + 64];
        const float sua = USC[ea], sub = USC[eb], sva = VSC[ea], svb = VSC[eb];
        const int hl = lane & 31, hi = lane >> 5;
        f32x2 uf[16];
        {
            const bf16_t* ur = u2 + (size_t)tok * D + hl * 32;
#pragma unroll
            for (int q = 0; q < 4; ++q) {
                const uint4 qv = *(const uint4*)(ur + q * 8);
                uf[q * 4 + 0] = f32x2{bf_lo(qv.x), bf_hi(qv.x)}; uf[q * 4 + 1] = f32x2{bf_lo(qv.y), bf_hi(qv.y)};
                uf[q * 4 + 2] = f32x2{bf_lo(qv.z), bf_hi(qv.z)}; uf[q * 4 + 3] = f32x2{bf_lo(qv.w), bf_hi(qv.w)};
            }
        }
        float act_a = 0.f, act_b = 0.f;
#pragma unroll
        for (int hb = 0; hb < 2; ++hb) {
            const int esel = hb ? eb : ea;
            float actv = 0.f;
            for (int jb = 0; jb < 64; jb += 32) {
                u32x4 x[16];
#pragma unroll
                for (int i = 0; i < 16; ++i) {
                    const int eA = rdlanei(esel, jb + i), eB = rdlanei(esel, jb + 16 + i);
                    const int e = hi ? eB : eA;
                    x[i] = *(const u32x4*)(UT + (size_t)e * 512 + hl * 16);
                }
#pragma unroll
                for (int i = 0; i < 16; ++i) {
                    f32x2 a2 = f32x2{0.f, 0.f};
#pragma unroll
                    for (int wq = 0; wq < 4; ++wq) {
                        a2 += __builtin_amdgcn_cvt_scalef32_pk_f32_fp4(x[i][wq], 1.0f, 0) * uf[wq * 4 + 0];
                        a2 += __builtin_amdgcn_cvt_scalef32_pk_f32_fp4(x[i][wq], 1.0f, 1) * uf[wq * 4 + 1];
                        a2 += __builtin_amdgcn_cvt_scalef32_pk_f32_fp4(x[i][wq], 1.0f, 2) * uf[wq * 4 + 2];
                        a2 += __builtin_amdgcn_cvt_scalef32_pk_f32_fp4(x[i][wq], 1.0f, 3) * uf[wq * 4 + 3];
                    }
                    const float hs = dpp_sum_half(a2.x + a2.y);
                    const float totA = rdlane(hs, 31), totB = rdlane(hs, 63);
                    actv = (lane == jb + i) ? totA : actv;
                    actv = (lane == jb + 16 + i) ? totB : actv;
                }
            }
            if (hb) act_b = actv; else act_a = actv;
        }
        const float cfa = ga * gelu_exact(act_a * sua) * sva;
        const float cfb = gb * gelu_exact(act_b * sub) * svb;
        f32x2 ya[16];
#pragma unroll
        for (int i = 0; i < 16; ++i) ya[i] = f32x2{0.f, 0.f};
#pragma unroll
        for (int hb = 0; hb < 2; ++hb) {
            const int esel = hb ? eb : ea;
            const float csel = hb ? cfb : cfa;
            for (int jb = 0; jb < 64; jb += 32) {
                u32x4 x[16];
#pragma unroll
                for (int i = 0; i < 16; ++i) {
                    const int eA = rdlanei(esel, jb + i), eB = rdlanei(esel, jb + 16 + i);
                    const int e = hi ? eB : eA;
                    x[i] = *(const u32x4*)(VT + (size_t)e * 512 + hl * 16);
                }
#pragma unroll
                for (int i = 0; i < 16; ++i) {
                    const float cA = rdlane(csel, jb + i), cB = rdlane(csel, jb + 16 + i);
                    const float cf = hi ? cB : cA;
                    const f32x2 c2 = f32x2{cf, cf};
#pragma unroll
                    for (int wq = 0; wq < 4; ++wq) {
                        ya[wq * 4 + 0] += c2 * __builtin_amdgcn_cvt_scalef32_pk_f32_fp4(x[i][wq], 1.0f, 0);
                        ya[wq * 4 + 1] += c2 * __builtin_amdgcn_cvt_scalef32_pk_f32_fp4(x[i][wq], 1.0f, 1);
                        ya[wq * 4 + 2] += c2 * __builtin_amdgcn_cvt_scalef32_pk_f32_fp4(x[i][wq], 1.0f, 2);
                        ya[wq * 4 + 3] += c2 * __builtin_amdgcn_cvt_scalef32_pk_f32_fp4(x[i][wq], 1.0f, 3);
                    }
                }
            }
        }
#pragma unroll
        for (int i = 0; i < 16; ++i) { ya[i].x += __shfl_xor(ya[i].x, 32); ya[i].y += __shfl_xor(ya[i].y, 32); }
        const int cbase = hl * 32 + hi * 16;
        float* xo = p.out + (size_t)tok * D + cbase;
        const float* g2 = mod + (size_t)seq_of(tok) * NMOD + 5120 + cbase;
        float r[16];
        float x1v[16];
        {
            float sa = 0.f;
#pragma unroll
            for (int i = 0; i < 4; ++i) { const float4 t4 = *(const float4*)(xo + i * 4); x1v[i * 4] = t4.x; x1v[i * 4 + 1] = t4.y; x1v[i * 4 + 2] = t4.z; x1v[i * 4 + 3] = t4.w; sa += t4.x + t4.y + t4.z + t4.w; }
            const float m1 = wave_sum(sa) * (1.f / 1024.f);
            float qa = 0.f;
#pragma unroll
            for (int i = 0; i < 16; ++i) { x1v[i] -= m1; qa += x1v[i] * x1v[i]; }
            const float rs1 = rsqrtf(wave_sum(qa) * (1.f / 1024.f) + LN_EPS);
#pragma unroll
            for (int i = 0; i < 4; ++i) {
                const float4 g4 = *(const float4*)(p.ln1_g + cbase + i * 4), b4 = *(const float4*)(p.ln1_b + cbase + i * 4);
                x1v[i * 4] = x1v[i * 4] * rs1 * g4.x + b4.x; x1v[i * 4 + 1] = x1v[i * 4 + 1] * rs1 * g4.y + b4.y;
                x1v[i * 4 + 2] = x1v[i * 4 + 2] * rs1 * g4.z + b4.z; x1v[i * 4 + 3] = x1v[i * 4 + 3] * rs1 * g4.w + b4.w;
            }
        }
        float s1 = 0.f;
#pragma unroll
        for (int i = 0; i < 4; ++i) {
            const float4 xv = float4{x1v[i * 4], x1v[i * 4 + 1], x1v[i * 4 + 2], x1v[i * 4 + 3]}, gv = *(const float4*)(g2 + i * 4);
            const f32x2 y0 = hi ? ya[8 + i * 2] : ya[i * 2], y1 = hi ? ya[8 + i * 2 + 1] : ya[i * 2 + 1];
            r[i * 4 + 0] = ALPHA * xv.x + (1.f + gv.x) * y0.x; r[i * 4 + 1] = ALPHA * xv.y + (1.f + gv.y) * y0.y;
            r[i * 4 + 2] = ALPHA * xv.z + (1.f + gv.z) * y1.x; r[i * 4 + 3] = ALPHA * xv.w + (1.f + gv.w) * y1.y;
            s1 += r[i * 4] + r[i * 4 + 1] + r[i * 4 + 2] + r[i * 4 + 3];
        }
        const float mean = wave_sum(s1) * (1.f / 1024.f);
        float s2 = 0.f;
#pragma unroll
        for (int i = 0; i < 16; ++i) { r[i] -= mean; s2 += r[i] * r[i]; }
        const float rstd = rsqrtf(wave_sum(s2) * (1.f / 1024.f) + LN_EPS);
#pragma unroll
        for (int i = 0; i < 4; ++i) {
            const float4 la = *(const float4*)(p.ln2_g + cbase + i * 4), ba = *(const float4*)(p.ln2_b + cbase + i * 4);
            *(float4*)(xo + i * 4) = float4{r[i * 4] * rstd * la.x + ba.x, r[i * 4 + 1] * rstd * la.y + ba.y, r[i * 4 + 2] * rstd * la.z + ba.z, r[i * 4 + 3] * rstd * la.w + ba.w};
        }
    }
}

__global__ void __launch_bounds__(512, 2) mk_fwd(Params p, int ph_lo, int ph_hi, int use_cg) {
    extern __shared__ __attribute__((aligned(16))) unsigned char smem[];
    volatile LAS unsigned* xbw = (volatile LAS unsigned*)((LAS unsigned char*)smem + SMEM_BYTES);
    XcdBarrier bar; bar.bar = (unsigned*)(p.ws + WS_CTL) + CW_BAR; bar.x = 0; bar.st = xbw;
    if (ph_hi - ph_lo > 1 && !use_cg) {
        if (threadIdx.x < 4) xbw[threadIdx.x] = 0u;
        __syncthreads();
        bar = xcd_barrier_post((unsigned*)(p.ws + WS_CTL) + CW_BAR, xbw);
    }
#define SEAM(k) do { if (ph_lo <= (k) && (k) + 1 < ph_hi) { if (use_cg) cg::this_grid().sync(); else xcd_barrier(bar); } } while (0)
#define RUN(k) (ph_lo <= (k) && (k) < ph_hi)
    if (RUN(0)) phase0(p, smem);
    SEAM(0);
    if (RUN(1)) phase1(p, smem);
    SEAM(1);
    if (RUN(2)) phase2(p, smem);
    SEAM(2);
#ifndef REPA
#define REPA 1
#endif
#ifndef REPB
#define REPB 1
#endif
#ifndef REPC
#define REPC 1
#endif
#ifndef REPD
#define REPD 1
#endif
    if (RUN(3)) for (int r = 0; r < REPA; ++r) { phase3(p, smem); if (r + 1 < REPA) xcd_barrier(bar); }
    SEAM(3);
    if (RUN(4)) for (int r = 0; r < REPB; ++r) { phase4(p, smem); if (r + 1 < REPB) xcd_barrier(bar); }
    SEAM(4);
    if (RUN(5)) phase5(p, smem);
    SEAM(5);
    if (RUN(6)) phase6(p, smem);
    SEAM(6);
    if (RUN(7)) phase7(p);
    SEAM(7);
    if (RUN(8)) for (int r = 0; r < REPC; ++r) { phase8a(p, smem); if (r + 1 < REPC) xcd_barrier(bar); }
    SEAM(8);
    if (RUN(9)) for (int r = 0; r < REPD; ++r) { phase8(p, smem); if (r + 1 < REPD) xcd_barrier(bar); }
    SEAM(9);
    if (RUN(10)) phase10(p, smem);
}

extern "C" void kernel_launch(void* const* d_in, const int* in_sizes, int n_in, void* d_out, int out_size, void* d_ws, size_t ws_size, hipStream_t stream) {
    static int grid = 0;
    if (grid == 0) {
        int dev = 0, cus = 0, per_cu = 0;
        (void)hipGetDevice(&dev);
        (void)hipDeviceGetAttribute(&cus, hipDeviceAttributeMultiprocessorCount, dev);
        (void)hipFuncSetAttribute((const void*)mk_fwd, hipFuncAttributeMaxDynamicSharedMemorySize, LDS_DYN);
        (void)hipOccupancyMaxActiveBlocksPerMultiprocessor(&per_cu, (const void*)mk_fwd, 512, LDS_DYN);
        if (per_cu < 1) fprintf(stderr, "kernel_launch: occupancy query says %d workgroups per CU\n", per_cu);
        grid = cus;
        if (ws_size < WS_END) fprintf(stderr, "kernel_launch: workspace too small: %zu < %zu\n", ws_size, (size_t)WS_END);
    }
    Params p{};
    const float** f = (const float**)&p;
    for (int i = 0; i < 24; ++i) f[i] = (const float*)d_in[i];
    p.out = (float*)d_out; p.ws = (unsigned char*)d_ws;
    (void)hipMemsetAsync((unsigned char*)d_ws + WS_CTL, 0, 65536, stream);
    int lo = 0, hi = NPH, ucg = 0;
    void* args[] = {&p, &lo, &hi, &ucg};
    hipError_t e = hipLaunchCooperativeKernel((const void*)mk_fwd, dim3(grid), dim3(512), args, LDS_DYN, stream);
    if (e != hipSuccess) fprintf(stderr, "cooperative launch failed: %s (grid %d)\n", hipGetErrorString(e), grid);
}
#ifdef TEST4
__global__ void __launch_bounds__(512, 2) t4(Params p) { extern __shared__ __attribute__((aligned(16))) unsigned char sm4[]; phase4(p, sm4); }
__global__ void __launch_bounds__(512, 2) t4s(Params p) { extern __shared__ __attribute__((aligned(16))) unsigned char sm4[]; p4_state_scan(p, sm4 + VHALF * SMEM_HALF, blockIdx.x * 2 + VHALF); }
__global__ void __launch_bounds__(512, 2) t3(Params p) { extern __shared__ __attribute__((aligned(16))) unsigned char sm4[]; phase3(p, sm4); }
__global__ void __launch_bounds__(512, 2) t6(Params p) { extern __shared__ __attribute__((aligned(16))) unsigned char sm4[]; phase6(p, sm4); }
#endif
```
